# Optimizing an MI355X kernel written in HIP

```python
import jax, jax.numpy as jnp
from jax import lax
import numpy as np

D_MODEL = 1024
BATCH = 4
SEQ = 8192
DEPTH = 4
DEC_BATCH = 16
DEC_SEQ = 64
PAST_LEN = 1024

CHUNK = 64
HEAD_DIM = D_MODEL // 16
D_A = 3 * D_MODEL // 8
D_B = 3 * D_MODEL // 8
D_C = D_MODEL - D_A - D_B
N_HEADS_B = D_B // HEAD_DIM
D_IN = 2 * D_A + 2 * D_B + 3 * D_C
CONV_A_WIDTH = 31
CONV_C_WIDTH = 3
GMLP_BLOCK = 128
D_FF = 2816
ALPHA = (2.0 * DEPTH) ** 0.25
BETA = (8.0 * DEPTH) ** -0.25
LN_EPS = 1e-5

kernel_name = "hybrid_streaming_conv_gmlp_encoder_step"


def layer_norm(x, g, b):
    xf = x.astype(jnp.float32)
    mu = jnp.mean(xf, axis=-1, keepdims=True)
    var = jnp.mean(jnp.square(xf - mu), axis=-1, keepdims=True)
    return ((xf - mu) * lax.rsqrt(var + LN_EPS) * g.astype(jnp.float32) + b.astype(jnp.float32)).astype(x.dtype)


def swiglu_ffn(x, w_in, w_out):
    gate, up = jnp.split(x @ w_in, 2, axis=-1)
    return (jax.nn.silu(gate) * up) @ w_out


def depthwise_causal_conv(x_ext, w):
    k, c = w.shape
    return lax.conv_general_dilated(
        x_ext, w[:, None, :].astype(x_ext.dtype), window_strides=(1,), padding='VALID',
        dimension_numbers=('NWC', 'WIO', 'NWC'), feature_group_count=c)


def chunk_causal_mask(length):
    pos = jnp.arange(length)
    return (pos[None, :] // CHUNK) <= (pos[:, None] // CHUNK)


def spatial_gating(u, v, w_s, b_s, block_len):
    bt, t, _ = v.shape
    w = jnp.where(chunk_causal_mask(block_len), w_s[:, :block_len, :block_len], 0.0).astype(v.dtype)
    vh = v.reshape(bt, t // block_len, block_len, N_HEADS_B, HEAD_DIM)
    s = jnp.einsum('hij,bnjhd->bnihd', w, vh) + b_s[:, :block_len].T[None, None, :, :, None]
    return u * s.reshape(bt, t, D_B)


def token_mixers(h, hist_a, hist_c, w_in, conv_a_w, conv_a_b, norm_a_g, norm_a_b,
                 norm_b_g, norm_b_b, w_s, b_s, conv_c_w, w_out, block_len):
    z = h @ w_in
    cuts = [D_A, 2 * D_A, 2 * D_A + D_B, 2 * D_A + 2 * D_B,
            2 * D_A + 2 * D_B + D_C, 2 * D_A + 2 * D_B + 2 * D_C]
    p_a, g_a, u_b, v_b, x_c, gate_b, gate_c = jnp.split(z, cuts, axis=-1)
    a = p_a * jax.nn.sigmoid(g_a)
    a_ext = jnp.concatenate([hist_a, a], axis=1)
    a_conv = depthwise_causal_conv(a_ext, conv_a_w) + conv_a_b
    out_a = jax.nn.silu(layer_norm(a_conv, norm_a_g, norm_a_b))
    new_hist_a = a_ext[:, -(CONV_A_WIDTH - 1):]
    v_n = layer_norm(v_b, norm_b_g, norm_b_b)
    out_b = spatial_gating(u_b, v_n, w_s, b_s, block_len)
    cx = gate_c * x_c
    c_ext = jnp.concatenate([hist_c, cx], axis=1)
    out_c = gate_b * depthwise_causal_conv(c_ext, conv_c_w)
    new_hist_c = c_ext[:, -(CONV_C_WIDTH - 1):]
    y = jnp.concatenate([out_a, out_b, out_c], axis=-1) @ w_out
    return y, new_hist_a, new_hist_c, v_n


def trunk(x, hist_a, hist_c, block_len, weights):
    (w_ffn1_in, w_ffn1_out, ln1_g, ln1_b, w_in, conv_a_w, conv_a_b, norm_a_g, norm_a_b,
     norm_b_g, norm_b_b, w_s, b_s, conv_c_w, w_out, ln2_g, ln2_b,
     w_ffn2_in, w_ffn2_out, ln3_g, ln3_b) = weights
    states_a, states_c, states_v = [], [], []
    for l in range(DEPTH):
        x = layer_norm(ALPHA * x + 0.5 * swiglu_ffn(x, w_ffn1_in[l], w_ffn1_out[l]), ln1_g[l], ln1_b[l])
        y, ha, hc, vn = token_mixers(x, hist_a[l], hist_c[l], w_in[l], conv_a_w[l], conv_a_b[l],
                                     norm_a_g[l], norm_a_b[l], norm_b_g[l], norm_b_b[l],
                                     w_s[l], b_s[l], conv_c_w[l], w_out[l], block_len)
        x = layer_norm(ALPHA * x + y, ln2_g[l], ln2_b[l])
        x = layer_norm(ALPHA * x + 0.5 * swiglu_ffn(x, w_ffn2_in[l], w_ffn2_out[l]), ln3_g[l], ln3_b[l])
        states_a.append(ha)
        states_c.append(hc)
        states_v.append(vn)
    return x, jnp.stack(states_a), jnp.stack(states_c), jnp.stack(states_v)


def setup_inputs(seed: int = 0) -> dict:
    key = jax.random.key(seed)
    ks = iter(jax.random.split(key, 32))
    nrm = lambda shape, s: s * jax.random.normal(next(ks), shape, jnp.float32)
    L = DEPTH
    return {
        "x_prompt": nrm((BATCH, SEQ, D_MODEL), 1.0),
        "x_sample": nrm((DEC_BATCH, DEC_SEQ, D_MODEL), 1.0),
        "cache_conv_a": nrm((L, DEC_BATCH, CONV_A_WIDTH - 1, D_A), 0.5),
        "cache_conv_c": nrm((L, DEC_BATCH, CONV_C_WIDTH - 1, D_C), 0.5),
        "w_ffn1_in": nrm((L, D_MODEL, 2 * D_FF), D_MODEL ** -0.5),
        "w_ffn1_out": nrm((L, D_FF, D_MODEL), BETA * D_FF ** -0.5),
        "ln1_g": 1.0 + nrm((L, D_MODEL), 0.01),
        "ln1_b": nrm((L, D_MODEL), 0.01),
        "w_in": nrm((L, D_MODEL, D_IN), D_MODEL ** -0.5),
        "conv_a_w": nrm((L, CONV_A_WIDTH, D_A), CONV_A_WIDTH ** -0.5),
        "conv_a_b": nrm((L, D_A), 0.01),
        "norm_a_g": 1.0 + nrm((L, D_A), 0.01),
        "norm_a_b": nrm((L, D_A), 0.01),
        "norm_b_g": 1.0 + nrm((L, D_B), 0.01),
        "norm_b_b": nrm((L, D_B), 0.01),
        "w_s": nrm((L, N_HEADS_B, GMLP_BLOCK, GMLP_BLOCK), 0.5 * GMLP_BLOCK ** -0.5),
        "b_s": 1.0 + nrm((L, N_HEADS_B, GMLP_BLOCK), 0.01),
        "conv_c_w": nrm((L, CONV_C_WIDTH, D_C), CONV_C_WIDTH ** -0.5),
        "w_out": nrm((L, D_MODEL, D_MODEL), BETA * D_MODEL ** -0.5),
        "ln2_g": 1.0 + nrm((L, D_MODEL), 0.01),
        "ln2_b": nrm((L, D_MODEL), 0.01),
        "w_ffn2_in": nrm((L, D_MODEL, 2 * D_FF), D_MODEL ** -0.5),
        "w_ffn2_out": nrm((L, D_FF, D_MODEL), BETA * D_FF ** -0.5),
        "ln3_g": 1.0 + nrm((L, D_MODEL), 0.01),
        "ln3_b": nrm((L, D_MODEL), 0.01),
    }


def reference(x_prompt, x_sample, cache_conv_a, cache_conv_c, w_ffn1_in, w_ffn1_out, ln1_g, ln1_b,
              w_in, conv_a_w, conv_a_b, norm_a_g, norm_a_b, norm_b_g, norm_b_b, w_s, b_s,
              conv_c_w, w_out, ln2_g, ln2_b, w_ffn2_in, w_ffn2_out, ln3_g, ln3_b):
    weights = (w_ffn1_in, w_ffn1_out, ln1_g, ln1_b, w_in, conv_a_w, conv_a_b, norm_a_g, norm_a_b,
               norm_b_g, norm_b_b, w_s, b_s, conv_c_w, w_out, ln2_g, ln2_b,
               w_ffn2_in, w_ffn2_out, ln3_g, ln3_b)
    bp = x_prompt.shape[0]
    zeros_a = jnp.zeros((DEPTH, bp, CONV_A_WIDTH - 1, D_A), x_prompt.dtype)
    zeros_c = jnp.zeros((DEPTH, bp, CONV_C_WIDTH - 1, D_C), x_prompt.dtype)
    y_prompt, st_a_p, st_c_p, _ = trunk(x_prompt, zeros_a, zeros_c, GMLP_BLOCK, weights)
    y_sample, st_a_s, st_c_s, st_v_s = trunk(x_sample, cache_conv_a, cache_conv_c, x_sample.shape[1], weights)
    return (y_prompt, y_sample, st_a_p, st_c_p, st_a_s, st_c_s, st_v_s)
```

```cpp
#include <hip/hip_runtime.h>
#include <hip/hip_cooperative_groups.h>
#include <cstdio>
namespace cg = cooperative_groups;
namespace pg8 {
__device__ __forceinline__ int opaque_tid() { int t = threadIdx.x; asm volatile("" : "+v"(t)); return t; }
#define PG8_LAS __attribute__((address_space(3)))
typedef unsigned short bf16_t;
typedef short bf16x8 __attribute__((ext_vector_type(8)));
typedef float f32x4 __attribute__((ext_vector_type(4)));
typedef unsigned u32x4 __attribute__((ext_vector_type(4)));
constexpr int BM = 256, BK = 64, HALF = 128, HTB = HALF * BK * 2  , STAGE_BYTES = 8 * HTB, NXCD = 8, WGM = 8;

__host__ __device__ __forceinline__ int lds_byte(int r, int c) { const int st = (r >> 4) * 2 + (c >> 5), rr = r & 15, cc = c & 31, ob = rr * 64 + cc * 2; return st * 1024 + (ob ^ (((ob >> 9) & 1) << 5)); }
__host__ __device__ __forceinline__ void stage_rc(int b, int& R, int& C) { const int st = b / 1024, sb = b % 1024, swz = sb ^ (((sb >> 9) & 1) << 5); R = (st >> 1) * 16 + swz / 64; C = (st & 1) * 32 + (swz % 64) / 2; }
__host__ __device__ __forceinline__ int perm32(int rho) { const int n = rho >> 4, i = rho & 15; return 8 * (i >> 2) + 4 * n + (i & 3); }

struct Unit { int pm, pn; };
struct Gemm { const bf16_t* A; const bf16_t* Bt; int M, N, K; };

struct StaticOrder {
    int nM, nN, nwg, G, c;
    __host__ __device__ void init(int M, int N, int G_, int c_) { nM = M / BM; nN = N / BM; nwg = nM * nN; G = G_; c = c_; }
    __host__ __device__ bool next(int i, Unit& u) const {
        const long L = (long)i * G + c; if (L >= nwg) return false;
        int wgid = (int)L; { const int q = nwg / NXCD, r = nwg % NXCD, xcd = wgid % NXCD, off = wgid / NXCD; wgid = (xcd < r ? xcd * (q + 1) : r * (q + 1) + (xcd - r) * q) + off; }
        const int nig = WGM * nN, gid = wgid / nig, fm = gid * WGM, gsz = (nM - fm) < WGM ? (nM - fm) : WGM;
        u.pm = fm + ((wgid % nig) % gsz); u.pn = (wgid % nig) / gsz; return true;
    }
    __device__ __forceinline__ void a_ready(const Unit&) const {}
    __device__ __forceinline__ void done(const Unit&) const {}
};

__device__ __forceinline__ unsigned cvt_pk_bf16(float lo, float hi) { unsigned r; asm volatile("v_cvt_pk_bf16_f32 %0, %1, %2" : "=v"(r) : "v"(lo), "v"(hi)); return r; }
__device__ __forceinline__ float bf_lo(unsigned w) { return __uint_as_float(w << 16); }
__device__ __forceinline__ float bf_hi(unsigned w) { return __uint_as_float(w & 0xffff0000u); }
constexpr float LN_EPS_F = 1e-5f;
constexpr float ALPHA_F = 1.6817928305074290f;
typedef long long i64x2 __attribute__((ext_vector_type(2)));
constexpr float ST_SCALE = 1048576.0f;
__device__ __forceinline__ void row_stats(const long long* st, int r, float& mu, float& rstd) {
    const i64x2 v = *(const i64x2*)(st + 2 * r);
    const float sx = (float)v.x * (1.0f / ST_SCALE), sy = (float)v.y * (1.0f / ST_SCALE);
    mu = sx * (1.0f / 1024.0f); const float var = sy * (1.0f / 1024.0f) - mu * mu; rstd = rsqrtf(var + LN_EPS_F);
}
__device__ __forceinline__ float silu_f(float g) { return g * __builtin_amdgcn_rcpf(1.0f + __expf(-g)); }
__device__ __forceinline__ float sigmoid_f(float g) { return __builtin_amdgcn_rcpf(1.0f + __expf(-g)); }

struct EpiSwiGLU {
    static constexpr bool PERM = true, AFTER_DRAIN = false;
    bf16_t* H; const long long* st; const float* cs; const float* bw;
    __device__ __forceinline__ void operator()(const f32x4 (&acc)[2][2][4][2], const Unit& u, int wr, int wc, int fr, int fq) const {
        const int row0 = u.pm * BM + wr * 64 + fr;
        const int nb = u.pn * BM + wc * 32 + 8 * fq;
        const int hc = u.pn * 128 + wc * 32 + 8 * fq;
        f32x4 csg[2], bwg[2], csu[2], bwu[2];
#pragma unroll
        for (int n = 0; n < 2; ++n) { csg[n] = *(const f32x4*)(cs + nb + 4 * n); bwg[n] = *(const f32x4*)(bw + nb + 4 * n); csu[n] = *(const f32x4*)(cs + nb + 128 + 4 * n); bwu[n] = *(const f32x4*)(bw + nb + 128 + 4 * n); }
#pragma unroll
        for (int ai = 0; ai < 2; ++ai)
#pragma unroll
            for (int m = 0; m < 4; ++m) {
                const int r = row0 + ai * HALF + m * 16; float mu, rstd; row_stats(st, r, mu, rstd);
                float h[8];
#pragma unroll
                for (int n = 0; n < 2; ++n) {
                    const f32x4 g = (acc[ai][0][m][n] - mu * csg[n]) * rstd + bwg[n];
                    const f32x4 up = (acc[ai][1][m][n] - mu * csu[n]) * rstd + bwu[n];
#pragma unroll
                    for (int j = 0; j < 4; ++j) h[4 * n + j] = silu_f(g[j]) * up[j];
                }
                u32x4 w; w.x = cvt_pk_bf16(h[0], h[1]); w.y = cvt_pk_bf16(h[2], h[3]); w.z = cvt_pk_bf16(h[4], h[5]); w.w = cvt_pk_bf16(h[6], h[7]);
                *(u32x4*)(H + (size_t)r * 2816 + hc) = w;
            }
    }
};
struct EpiZ {
    static constexpr bool PERM = true, AFTER_DRAIN = false;
    bf16_t* Z; const long long* st; const float* cs; const float* bw;
    __device__ __forceinline__ void operator()(const f32x4 (&acc)[2][2][4][2], const Unit& u, int wr, int wc, int fr, int fq) const {
        const int row0 = u.pm * BM + wr * 64 + fr;
        const int c0 = u.pn * BM + wc * 32 + 8 * fq;
        f32x4 csv[2][2], bwv[2][2];
#pragma unroll
        for (int bj = 0; bj < 2; ++bj)
#pragma unroll
            for (int n = 0; n < 2; ++n) { csv[bj][n] = *(const f32x4*)(cs + c0 + bj * HALF + 4 * n); bwv[bj][n] = *(const f32x4*)(bw + c0 + bj * HALF + 4 * n); }
#pragma unroll
        for (int ai = 0; ai < 2; ++ai)
#pragma unroll
            for (int m = 0; m < 4; ++m) {
                const int r = row0 + ai * HALF + m * 16; float mu, rstd; row_stats(st, r, mu, rstd);
#pragma unroll
                for (int bj = 0; bj < 2; ++bj) {
                    const f32x4 v0 = (acc[ai][bj][m][0] - mu * csv[bj][0]) * rstd + bwv[bj][0];
                    const f32x4 v1 = (acc[ai][bj][m][1] - mu * csv[bj][1]) * rstd + bwv[bj][1];
                    u32x4 w; w.x = cvt_pk_bf16(v0[0], v0[1]); w.y = cvt_pk_bf16(v0[2], v0[3]); w.z = cvt_pk_bf16(v1[0], v1[1]); w.w = cvt_pk_bf16(v1[2], v1[3]);
                    *(u32x4*)(Z + (size_t)r * 2304 + c0 + bj * HALF) = w;
                }
            }
    }
};
struct EpiRes {
    static constexpr bool PERM = true, AFTER_DRAIN = false;
    bf16_t* P; float* outf; const long long* st_old; const float* g; const float* b; long long* st_new; float scale;
    __device__ __forceinline__ void operator()(const f32x4 (&acc)[2][2][4][2], const Unit& u, int wr, int wc, int fr, int fq) const {
        const int row0 = u.pm * BM + wr * 64 + fr;
        const int c0 = u.pn * BM + wc * 32 + 8 * fq;
#pragma unroll
        for (int ai = 0; ai < 2; ++ai)
#pragma unroll
            for (int m = 0; m < 4; ++m) {
                const int r = row0 + ai * HALF + m * 16;
                float mu, rs; row_stats(st_old, r, mu, rs); rs *= ALPHA_F;
                float s = 0.f, ss = 0.f;
#pragma unroll
                for (int bj = 0; bj < 2; ++bj) {
                    const int c = c0 + bj * HALF;
                    const f32x4 g0 = *(const f32x4*)(g + c), g1 = *(const f32x4*)(g + c + 4), b0 = *(const f32x4*)(b + c), b1 = *(const f32x4*)(b + c + 4);
                    const u32x4 pw = *(const u32x4*)(P + (size_t)r * 1024 + c);
                    f32x4 x0, x1;
                    x0[0] = bf_lo(pw.x); x0[1] = bf_hi(pw.x); x0[2] = bf_lo(pw.y); x0[3] = bf_hi(pw.y);
                    x1[0] = bf_lo(pw.z); x1[1] = bf_hi(pw.z); x1[2] = bf_lo(pw.w); x1[3] = bf_hi(pw.w);
                    f32x4 v0 = ((x0 - mu) * rs) * g0 + (b0 * ALPHA_F + scale * acc[ai][bj][m][0]);
                    f32x4 v1 = ((x1 - mu) * rs) * g1 + (b1 * ALPHA_F + scale * acc[ai][bj][m][1]);
                    if (outf) {
                        *(f32x4*)(outf + (size_t)r * 1024 + c) = v0; *(f32x4*)(outf + (size_t)r * 1024 + c + 4) = v1;
                    } else {
                        u32x4 w; w.x = cvt_pk_bf16(v0[0], v0[1]); w.y = cvt_pk_bf16(v0[2], v0[3]); w.z = cvt_pk_bf16(v1[0], v1[1]); w.w = cvt_pk_bf16(v1[2], v1[3]);
                        *(u32x4*)(P + (size_t)r * 1024 + c) = w;
                        v0[0] = bf_lo(w.x); v0[1] = bf_hi(w.x); v0[2] = bf_lo(w.y); v0[3] = bf_hi(w.y);
                        v1[0] = bf_lo(w.z); v1[1] = bf_hi(w.z); v1[2] = bf_lo(w.w); v1[3] = bf_hi(w.w);
                    }
                    s += (v0[0] + v0[1]) + (v0[2] + v0[3]) + (v1[0] + v1[1]) + (v1[2] + v1[3]);
                    ss += (v0[0] * v0[0] + v0[1] * v0[1]) + (v0[2] * v0[2] + v0[3] * v0[3]) + (v1[0] * v1[0] + v1[1] * v1[1]) + (v1[2] * v1[2] + v1[3] * v1[3]);
                }
                s += __shfl_xor(s, 16); s += __shfl_xor(s, 32); ss += __shfl_xor(ss, 16); ss += __shfl_xor(ss, 32);
                if (fq == 0) {
                    __hip_atomic_fetch_add(st_new + 2 * r, __float2ll_rn(s * ST_SCALE), __ATOMIC_RELAXED, __HIP_MEMORY_SCOPE_AGENT);
                    __hip_atomic_fetch_add(st_new + 2 * r + 1, __float2ll_rn(ss * ST_SCALE), __ATOMIC_RELAXED, __HIP_MEMORY_SCOPE_AGENT); }
                asm volatile("" ::: "memory");
            }
    }
};

template <class Epi, class Sched, bool STAMP = false>
__device__ __forceinline__ void gemm_phase(PG8_LAS unsigned char* lds, const Gemm g, const Sched& S, const Epi& E, unsigned long long* stamps) {
    const int tid = opaque_tid(), wid = __builtin_amdgcn_readfirstlane(tid >> 6), lane = tid & 63, wr = wid >> 2, wc = wid & 3, fr = lane & 15, fq = lane >> 4;
    const int K = g.K, nt = K / BK;
    int ts_lo = 0, ts_hi = 0, nts = 0; const unsigned long long rt_entry = STAMP ? (unsigned long long)wall_clock64() : 0ull;
#define PG8_STAMP() do { if (STAMP && wid == 0 && nts < 64) { const unsigned long long _c = (unsigned long long)clock64(); \
        ts_lo = (lane == nts) ? (int)(unsigned)_c : ts_lo; ts_hi = (lane == nts) ? (int)(unsigned)(_c >> 32) : ts_hi; ++nts; } } while (0)
    PG8_STAMP();
    unsigned voffA[2], voffB[2];
#pragma unroll
    for (int i = 0; i < 2; ++i) { int R, C; stage_rc(tid * 16 + i * 8192, R, C); const int Rb = Epi::PERM ? ((R & ~31) + perm32(R & 31)) : R;
        voffA[i] = (unsigned)(R * K + C) * 2u; voffB[i] = (unsigned)(Rb * K + C) * 2u; }
    const size_t kstep = (size_t)(BK * 2);
    const size_t hstep = (size_t)HALF * K * 2;
    const size_t tstep = 2 * hstep;
    const unsigned ldsw = (unsigned)wid * 1024u;
    const int aoff = lds_byte(wr * 64 + fr, fq * 8), boff = lds_byte(wc * 32 + fr, fq * 8);
#define PG8_SA(b, h) (((b) * 2 + (h)) * HTB)
#define PG8_SB(b, h) ((4 + (b) * 2 + (h)) * HTB)
#define PG8_STAGE(bufoff, gbase, voff) do { _Pragma("unroll") for (int _i = 0; _i < 2; ++_i) \
        __builtin_amdgcn_global_load_lds((const unsigned*)((const char*)(gbase) + (voff)[_i]), (PG8_LAS unsigned*)(lds + (bufoff) + ldsw + _i * 8192), 16, 0, 0); } while (0)
#define PG8_LDA(dst, b, h) do { _Pragma("unroll") for (int m = 0; m < 4; ++m) _Pragma("unroll") for (int k = 0; k < 2; ++k) dst[m][k] = *(const PG8_LAS bf16x8*)(lds + PG8_SA(b, h) + aoff + m * 2048 + k * 1024); } while (0)
#define PG8_LDB(dst, b, h) do { _Pragma("unroll") for (int n = 0; n < 2; ++n) _Pragma("unroll") for (int k = 0; k < 2; ++k) dst[n][k] = *(const PG8_LAS bf16x8*)(lds + PG8_SB(b, h) + boff + n * 2048 + k * 1024); } while (0)
#define PG8_MMA(ai, bj, At, Bt) do { __builtin_amdgcn_s_setprio(1); _Pragma("unroll") for (int m = 0; m < 4; ++m) _Pragma("unroll") for (int n = 0; n < 2; ++n) _Pragma("unroll") for (int k = 0; k < 2; ++k) \
        acc[ai][bj][m][n] = __builtin_amdgcn_mfma_f32_16x16x32_bf16(Bt[n][k], At[m][k], acc[ai][bj][m][n], 0, 0, 0); __builtin_amdgcn_s_setprio(0); } while (0)
#define PG8_WAIT_V(n) asm volatile("s_waitcnt vmcnt(" #n ")" ::: "memory")
#define PG8_WAIT_L(n) asm volatile("s_waitcnt lgkmcnt(" #n ")" ::: "memory")
#define PG8_BAR __builtin_amdgcn_s_barrier()
#define PG8_SCHED __builtin_amdgcn_sched_barrier(0)
    Unit cur, nxt; int ui = 0;
    if (!S.next(0, cur)) return;
    f32x4 acc[2][2][4][2];
#pragma unroll
    for (int a = 0; a < 2; ++a)
#pragma unroll
        for (int b = 0; b < 2; ++b)
#pragma unroll
            for (int m = 0; m < 4; ++m)
#pragma unroll
                for (int n = 0; n < 2; ++n) acc[a][b][m][n] = (f32x4){0.f, 0.f, 0.f, 0.f};
    bf16x8 At[4][2], B0[2][2], B1[2][2];
    const char* cA = (const char*)g.A + (size_t)cur.pm * tstep; const char* cB = (const char*)g.Bt + (size_t)cur.pn * tstep;
    S.a_ready(cur);
    PG8_STAGE(PG8_SB(0, 0), cB, voffB); PG8_STAGE(PG8_SA(0, 0), cA, voffA); PG8_STAGE(PG8_SB(0, 1), cB + hstep, voffB); PG8_STAGE(PG8_SA(0, 1), cA + hstep, voffA);
    if (wr == 1) PG8_BAR;
    PG8_WAIT_V(4); PG8_BAR;
    PG8_STAGE(PG8_SB(1, 0), cB + kstep, voffB); PG8_STAGE(PG8_SA(1, 0), cA + kstep, voffA); PG8_STAGE(PG8_SB(1, 1), cB + hstep + kstep, voffB);
    PG8_WAIT_V(6); PG8_BAR;
    PG8_STAMP();
    for (;;) {
        const bool has_next = S.next(ui + 1, nxt);
        const char* nA = has_next ? (const char*)g.A + (size_t)nxt.pm * tstep : cA; const char* nB = has_next ? (const char*)g.Bt + (size_t)nxt.pn * tstep : cB;
        for (int t = 0; t < nt; t += 2) {
            const bool last = (t == nt - 2);
            const char* a1 = cA + (size_t)(t + 1) * kstep;
            const char* a2 = last ? nA : cA + (size_t)(t + 2) * kstep; const char* b2 = last ? nB : cB + (size_t)(t + 2) * kstep;
            const char* a3 = a2 + kstep; const char* b3 = b2 + kstep;
            if (last && has_next) S.a_ready(nxt);
            PG8_LDB(B0, 0, 0); PG8_SCHED; PG8_LDA(At, 0, 0); PG8_STAGE(PG8_SA(1, 1), a1 + hstep, voffA);
            PG8_WAIT_L(8); PG8_BAR; PG8_WAIT_L(0); PG8_MMA(0, 0, At, B0); PG8_BAR; PG8_SCHED;
            PG8_LDB(B1, 0, 1); PG8_STAGE(PG8_SB(0, 0), b2, voffB);
            PG8_BAR; PG8_WAIT_L(0); PG8_MMA(0, 1, At, B1); PG8_BAR;
            PG8_LDA(At, 0, 1); PG8_STAGE(PG8_SA(0, 0), a2, voffA);
            PG8_BAR; PG8_WAIT_L(0); PG8_MMA(1, 0, At, B0); PG8_BAR; PG8_SCHED;
            PG8_STAGE(PG8_SB(0, 1), b2 + hstep, voffB);
            PG8_WAIT_V(6); PG8_BAR; PG8_MMA(1, 1, At, B1); PG8_BAR;
            PG8_LDB(B0, 1, 0); PG8_SCHED; PG8_LDA(At, 1, 0); PG8_STAGE(PG8_SA(0, 1), a2 + hstep, voffA);
            PG8_WAIT_L(8); PG8_BAR; PG8_WAIT_L(0); PG8_MMA(0, 0, At, B0); PG8_BAR; PG8_SCHED;
            PG8_LDB(B1, 1, 1); PG8_STAGE(PG8_SB(1, 0), b3, voffB);
            PG8_BAR; PG8_WAIT_L(0); PG8_MMA(0, 1, At, B1); PG8_BAR;
            PG8_LDA(At, 1, 1); PG8_STAGE(PG8_SA(1, 0), a3, voffA);
            PG8_BAR; PG8_WAIT_L(0); PG8_MMA(1, 0, At, B0); PG8_BAR; PG8_SCHED;
            PG8_STAGE(PG8_SB(1, 1), b3 + hstep, voffB);
            PG8_WAIT_V(6); PG8_BAR; PG8_MMA(1, 1, At, B1); PG8_BAR;
        }
        PG8_STAMP();
        if constexpr (!Epi::AFTER_DRAIN) { E(acc, cur, wr, wc, fr, fq); S.done(cur); }
        PG8_STAMP();
        if (!has_next) break;
#pragma unroll
        for (int a = 0; a < 2; ++a)
#pragma unroll
            for (int b = 0; b < 2; ++b)
#pragma unroll
                for (int m = 0; m < 4; ++m)
#pragma unroll
                    for (int n = 0; n < 2; ++n) acc[a][b][m][n] = (f32x4){0.f, 0.f, 0.f, 0.f};
        cur = nxt; cA = nA; cB = nB; ++ui;
    }
    PG8_WAIT_V(0);
    if (wr == 0) PG8_BAR;
    PG8_BAR;
    if constexpr (Epi::AFTER_DRAIN) { E.fused(acc, cur, wr, wc, fr, fq, lds, wid, lane); S.done(cur); }
    PG8_STAMP();
    if (STAMP && wid == 0) { stamps[lane] = lane < nts ? (((unsigned long long)(unsigned)ts_hi << 32) | (unsigned)ts_lo) : 0ull;
        if (lane == 62) stamps[62] = rt_entry; if (lane == 63) stamps[63] = (unsigned long long)wall_clock64(); }
#undef PG8_STAMP
#undef PG8_SA
#undef PG8_SB
#undef PG8_STAGE
#undef PG8_LDA
#undef PG8_LDB
#undef PG8_MMA
#undef PG8_WAIT_V
#undef PG8_WAIT_L
#undef PG8_BAR
#undef PG8_SCHED
}
}

using pg8::bf16_t; using pg8::f32x4; using pg8::u32x4; using pg8::bf16x8;
using pg8::cvt_pk_bf16; using pg8::bf_lo; using pg8::bf_hi; using pg8::silu_f; using pg8::sigmoid_f; using pg8::LN_EPS_F;
typedef unsigned u32x2 __attribute__((ext_vector_type(2)));
constexpr int T_TOK = 33792, TP = 32768, NL = 4;
constexpr size_t SZ_WFI = (size_t)5632 * 1024 * 2, SZ_WFO = (size_t)1024 * 2816 * 2, SZ_WI = (size_t)2304 * 1024 * 2, SZ_WO = (size_t)1024 * 1024 * 2;
constexpr size_t WS_WFI = 0;
constexpr size_t WS_WFO = WS_WFI + 8 * SZ_WFI;
constexpr size_t WS_WI = WS_WFO + 8 * SZ_WFO;
constexpr size_t WS_WO = WS_WI + 4 * SZ_WI;
constexpr size_t WS_CSF = WS_WO + 4 * SZ_WO;
constexpr size_t WS_BWF = WS_CSF + 8 * 5632 * 4;
constexpr size_t WS_CSI = WS_BWF + 8 * 5632 * 4;
constexpr size_t WS_BWI = WS_CSI + 4 * 2304 * 4;
constexpr size_t WS_ONE = WS_BWI + 4 * 2304 * 4;
constexpr size_t WS_ZERO = WS_ONE + 4096;
constexpr size_t WS_ST = WS_ZERO + 4096;
constexpr size_t SZ_ST = (size_t)T_TOK * 16;
constexpr size_t WS_P = WS_ST + 13 * SZ_ST;
constexpr size_t WS_H = WS_P + (size_t)T_TOK * 1024 * 2;
constexpr size_t WS_MX = WS_H + (size_t)T_TOK * 2816 * 2;
constexpr size_t WS_END = WS_MX + (size_t)T_TOK * 1024 * 2;
constexpr size_t O_SAP = 34603008, O_SCP = 34787328, O_SAS = 34795520, O_SCS = 35532800, O_SVS = 35565568;
constexpr int LDS_BYTES = 131072;
constexpr int N_PHASES = 30;

struct Params { const float* in[25]; float* out; unsigned char* ws; int lo, hi; };

__device__ __forceinline__ unsigned short f2bf(float f) { unsigned u = __float_as_uint(f); u += 0x7FFFu + ((u >> 16) & 1u); return (unsigned short)(u >> 16); }
__device__ __forceinline__ float bf2f(unsigned short h) { return __uint_as_float(((unsigned)h) << 16); }
__device__ __forceinline__ float wave_sum(float v) {
#pragma unroll
    for (int o = 32; o >= 1; o >>= 1) v += __shfl_xor(v, o);
    return v;
}

__device__ __forceinline__ void prep_weight_unit(PG8_LAS unsigned char* lds, const float* src, int ldsrc, int scol, bf16_t* dst, int K, int n0, int kbeg, int nchunks,
                                                 const float* g, const float* b, float* cs_out, float* bw_out) {
    const int tid = pg8::opaque_tid(), c4 = tid & 31, kr = tid >> 5;
    PG8_LAS unsigned short* tile = (PG8_LAS unsigned short*)lds;
    float cs[4] = {0.f, 0.f, 0.f, 0.f}, bw[4] = {0.f, 0.f, 0.f, 0.f};
    for (int ch = 0; ch < nchunks; ++ch) {
        const int k0 = kbeg + ch * 64;
        f32x4 w[4]; float gk[4], bk[4];
#pragma unroll
        for (int i = 0; i < 4; ++i) { const int k = k0 + kr + 16 * i; w[i] = *(const f32x4*)(src + (size_t)k * ldsrc + scol + 4 * c4); gk[i] = g ? g[k] : 1.0f; bk[i] = b ? b[k] : 0.0f; }
        __syncthreads();
#pragma unroll
        for (int i = 0; i < 4; ++i)
#pragma unroll
            for (int e = 0; e < 4; ++e) { const unsigned short hb = f2bf(w[i][e] * gk[i]); tile[(4 * c4 + e) * 66 + kr + 16 * i] = hb; cs[e] += bf2f(hb); bw[e] += w[i][e] * bk[i]; }
        __syncthreads();
        const int n = tid >> 2, q = tid & 3;
        const PG8_LAS unsigned* rowp = (const PG8_LAS unsigned*)(tile + n * 66 + 16 * q);
        u32x4 o0, o1; o0.x = rowp[0]; o0.y = rowp[1]; o0.z = rowp[2]; o0.w = rowp[3]; o1.x = rowp[4]; o1.y = rowp[5]; o1.z = rowp[6]; o1.w = rowp[7];
        bf16_t* d = dst + (size_t)(n0 + n) * K + k0 + 16 * q;
        *(u32x4*)d = o0; *(u32x4*)(d + 8) = o1;
    }
    if (cs_out) {
        __syncthreads();
        PG8_LAS float* red = (PG8_LAS float*)(lds + 32768);
#pragma unroll
        for (int e = 0; e < 4; ++e) { red[(kr * 128 + 4 * c4 + e) * 2] = cs[e]; red[(kr * 128 + 4 * c4 + e) * 2 + 1] = bw[e]; }
        __syncthreads();
        if (tid < 128) { float a = 0.f, q = 0.f;
#pragma unroll
            for (int r = 0; r < 16; ++r) { a += red[(r * 128 + tid) * 2]; q += red[(r * 128 + tid) * 2 + 1]; }
            cs_out[n0 + tid] = a; bw_out[n0 + tid] = q; }
    }
    __syncthreads();
}

__device__ __forceinline__ void prep_phase(PG8_LAS unsigned char* lds, const Params& p) {
    unsigned char* ws = p.ws; const int G = gridDim.x;
    for (int idx = blockIdx.x; idx < 1256; idx += G) {
        if (idx < 352) {
            const int m = idx / 44, strip = idx % 44, l = m >> 1, f = m & 1, pn = strip >> 1, bj = strip & 1;
            const float* src = p.in[f ? 21 : 4] + (size_t)l * 1024 * 5632;
            const float* g = f ? p.in[19] + l * 1024 : (l ? p.in[23] + (l - 1) * 1024 : nullptr);
            const float* b = f ? p.in[20] + l * 1024 : (l ? p.in[24] + (l - 1) * 1024 : nullptr);
            prep_weight_unit(lds, src, 5632, bj * 2816 + 128 * pn, (bf16_t*)(ws + WS_WFI + m * SZ_WFI), 1024, strip * 128, 0, 16, g, b,
                             (float*)(ws + WS_CSF) + m * 5632, (float*)(ws + WS_BWF) + m * 5632);
        } else if (idx < 424) {
            const int j = idx - 352, l = j / 18, strip = j % 18;
            prep_weight_unit(lds, p.in[8] + (size_t)l * 1024 * 2304, 2304, strip * 128, (bf16_t*)(ws + WS_WI + l * SZ_WI), 1024, strip * 128, 0, 16, p.in[6] + l * 1024, p.in[7] + l * 1024,
                             (float*)(ws + WS_CSI) + l * 2304, (float*)(ws + WS_BWI) + l * 2304);
        } else if (idx < 1128) {
            const int j = idx - 424, m = j / 88, rem = j % 88, strip = rem / 11, kq = rem % 11, l = m >> 1, f = m & 1;
            prep_weight_unit(lds, p.in[f ? 22 : 5] + (size_t)l * 2816 * 1024, 1024, strip * 128, (bf16_t*)(ws + WS_WFO + m * SZ_WFO), 2816, strip * 128, kq * 256, 4, nullptr, nullptr, nullptr, nullptr);
        } else {
            const int j = idx - 1128, l = j / 32, rem = j % 32, strip = rem / 4, kq = rem % 4;
            prep_weight_unit(lds, p.in[18] + (size_t)l * 1024 * 1024, 1024, strip * 128, (bf16_t*)(ws + WS_WO + l * SZ_WO), 1024, strip * 128, kq * 256, 4, nullptr, nullptr, nullptr, nullptr);
        }
    }
    const size_t gt = (size_t)blockIdx.x * 512 + pg8::opaque_tid(), gn = (size_t)G * 512;
    bf16_t* P = (bf16_t*)(ws + WS_P);
    for (size_t i = gt; i < (size_t)T_TOK * 1024 / 8; i += gn) {
        const size_t e = i * 8; const float* s = e < (size_t)TP * 1024 ? p.in[0] + e : p.in[1] + (e - (size_t)TP * 1024);
        const f32x4 a = *(const f32x4*)s, c = *(const f32x4*)(s + 4);
        u32x4 w; w.x = cvt_pk_bf16(a[0], a[1]); w.y = cvt_pk_bf16(a[2], a[3]); w.z = cvt_pk_bf16(c[0], c[1]); w.w = cvt_pk_bf16(c[2], c[3]);
        *(u32x4*)(P + e) = w;
    }
    long long* st = (long long*)(ws + WS_ST);
    for (size_t i = gt; i < (size_t)13 * T_TOK; i += gn) { st[2 * i] = 0; st[2 * i + 1] = i < (size_t)T_TOK ? 1073731086ll : 0ll; }
    if (gt < 1024) { ((float*)(ws + WS_ONE))[gt] = 1.0f; ((float*)(ws + WS_ZERO))[gt] = 0.0f; }
}

__device__ __forceinline__ void mixer_a_unit(PG8_LAS unsigned char* lds, int u, int l, const bf16_t* Z, bf16_t* MX, const Params& p) {
    const int tid = pg8::opaque_tid(), tb = u * 32;
    const bool samp = tb >= TP;
    int b, t0, T, seqbase;
    if (!samp) { b = tb >> 13; t0 = tb & 8191; T = 8192; seqbase = b << 13; } else { const int rs = tb - TP; b = rs >> 6; t0 = rs & 63; T = 64; seqbase = TP + (b << 6); }
    PG8_LAS float* cv = (PG8_LAS float*)lds;
    __syncthreads();
    if (tid < 384) {
        const int c = tid;
        float a[62];
#pragma unroll
        for (int i = 0; i < 62; ++i) {
            const int t = t0 - 30 + i;
            if (t >= 0) { const size_t ro = (size_t)(seqbase + t) * 2304; a[i] = bf2f(Z[ro + c]) * sigmoid_f(bf2f(Z[ro + 384 + c])); }
            else a[i] = samp ? p.in[2][((size_t)(l * 16 + b) * 30 + (30 + t)) * 384 + c] : 0.f;
        }
        if (t0 + 32 == T) {
            float* so = samp ? p.out + O_SAS + (size_t)(l * 16 + b) * 30 * 384 : p.out + O_SAP + (size_t)(l * 4 + b) * 30 * 384;
#pragma unroll
            for (int i = 0; i < 30; ++i) so[i * 384 + c] = a[32 + i];
        }
        float w[31];
#pragma unroll
        for (int k = 0; k < 31; ++k) w[k] = p.in[9][(size_t)(l * 31 + k) * 384 + c];
        const float bias = p.in[10][l * 384 + c];
#pragma unroll
        for (int j = 0; j < 32; ++j) { float acc = bias;
#pragma unroll
            for (int k = 0; k < 31; ++k) acc += w[k] * a[j + k];
            cv[j * 384 + c] = acc; }
    }
    __syncthreads();
    const int wave = tid >> 6, lane = tid & 63;
    const float* ng = p.in[11] + l * 384; const float* nb = p.in[12] + l * 384;
#pragma unroll
    for (int tt = 0; tt < 4; ++tt) {
        const int j = wave * 4 + tt; const size_t row = (size_t)(seqbase + t0 + j);
        float x[6]; float s = 0.f;
#pragma unroll
        for (int i = 0; i < 6; ++i) { x[i] = cv[j * 384 + lane + 64 * i]; s += x[i]; }
        const float mean = wave_sum(s) * (1.0f / 384.0f); float q = 0.f;
#pragma unroll
        for (int i = 0; i < 6; ++i) { x[i] -= mean; q += x[i] * x[i]; }
        const float rstd = rsqrtf(wave_sum(q) * (1.0f / 384.0f) + LN_EPS_F);
#pragma unroll
        for (int i = 0; i < 6; ++i) { const int c = lane + 64 * i; const float y = x[i] * rstd * ng[c] + nb[c]; MX[row * 1024 + c] = f2bf(silu_f(y)); }
    }
}
__device__ __forceinline__ void mixer_b_unit(PG8_LAS unsigned char* lds, int blk, int l, const bf16_t* Z, bf16_t* MX, const Params& p) {
    const int tid = pg8::opaque_tid(), wave = tid >> 6, lane = tid & 63, fr = lane & 15, fq = lane >> 4;
    const int row0 = blk * 128; const bool samp = row0 >= TP;
    const float* ng = p.in[13] + l * 384; const float* nb = p.in[14] + l * 384;
    PG8_LAS unsigned short* vT = (PG8_LAS unsigned short*)lds;
    __syncthreads();
    float gg[6], bb[6];
#pragma unroll
    for (int i = 0; i < 3; ++i) { const int c = 2 * lane + 128 * i; gg[2 * i] = ng[c]; gg[2 * i + 1] = ng[c + 1]; bb[2 * i] = nb[c]; bb[2 * i + 1] = nb[c + 1]; }
    for (int jj = 0; jj < 16; ++jj) {
        const int j = wave * 16 + jj; const size_t row = (size_t)(row0 + j);
        float v[6]; float s = 0.f;
#pragma unroll
        for (int i = 0; i < 3; ++i) { const unsigned w = *(const unsigned*)(Z + row * 2304 + 1152 + 2 * lane + 128 * i); v[2 * i] = bf_lo(w); v[2 * i + 1] = bf_hi(w); s += v[2 * i] + v[2 * i + 1]; }
        const float mean = wave_sum(s) * (1.0f / 384.0f); float q = 0.f;
#pragma unroll
        for (int i = 0; i < 6; ++i) { v[i] -= mean; q += v[i] * v[i]; }
        const float rstd = rsqrtf(wave_sum(q) * (1.0f / 384.0f) + LN_EPS_F);
#pragma unroll
        for (int i = 0; i < 3; ++i) {
            const int c = 2 * lane + 128 * i;
            const float y0 = v[2 * i] * rstd * gg[2 * i] + bb[2 * i], y1 = v[2 * i + 1] * rstd * gg[2 * i + 1] + bb[2 * i + 1];
            if (samp) { float* so = p.out + O_SVS + ((size_t)l * 1024 + (row - TP)) * 384 + c; so[0] = y0; so[1] = y1; }
            vT[c * 136 + j] = f2bf(y0); vT[(c + 1) * 136 + j] = f2bf(y1);
        }
    }
    __syncthreads();
    const int i_loc = wave * 16 + fr;
    const size_t orow = (size_t)(row0 + i_loc);
    for (int h = 0; h < 6; ++h) {
        f32x4 acc[4];
#pragma unroll
        for (int dt = 0; dt < 4; ++dt) acc[dt] = (f32x4){0.f, 0.f, 0.f, 0.f};
        const float* wh = p.in[15] + (size_t)(l * 6 + h) * 128 * 128;
#pragma unroll
        for (int ks = 0; ks < 4; ++ks) {
            const int j0 = ks * 32 + fq * 8;
            bool valid; const float* src;
            if (!samp) { valid = (j0 >> 6) <= (i_loc >> 6); src = wh + i_loc * 128 + j0; }
            else { valid = (j0 >> 6) == (i_loc >> 6); src = wh + (i_loc & 63) * 128 + (j0 & 63); }
            f32x4 w0 = (f32x4){0.f, 0.f, 0.f, 0.f}, w1 = w0;
            if (valid) { w0 = *(const f32x4*)src; w1 = *(const f32x4*)(src + 4); }
            union { bf16x8 v; unsigned u[4]; } wf;
            wf.u[0] = cvt_pk_bf16(w0[0], w0[1]); wf.u[1] = cvt_pk_bf16(w0[2], w0[3]); wf.u[2] = cvt_pk_bf16(w1[0], w1[1]); wf.u[3] = cvt_pk_bf16(w1[2], w1[3]);
#pragma unroll
            for (int dt = 0; dt < 4; ++dt) {
                const bf16x8 vf = *(const PG8_LAS bf16x8*)(vT + (h * 64 + dt * 16 + fr) * 136 + j0);
                acc[dt] = __builtin_amdgcn_mfma_f32_16x16x32_bf16(vf, wf.v, acc[dt], 0, 0, 0);
            }
        }
        const float bias = p.in[16][(l * 6 + h) * 128 + (samp ? (i_loc & 63) : i_loc)];
#pragma unroll
        for (int dt = 0; dt < 4; ++dt) {
            const int d = h * 64 + dt * 16 + fq * 4;
            const u32x2 uw = *(const u32x2*)(Z + orow * 2304 + 768 + d);
            const float o0 = bf_lo(uw.x) * (acc[dt][0] + bias), o1 = bf_hi(uw.x) * (acc[dt][1] + bias), o2 = bf_lo(uw.y) * (acc[dt][2] + bias), o3 = bf_hi(uw.y) * (acc[dt][3] + bias);
            u32x2 ow; ow.x = cvt_pk_bf16(o0, o1); ow.y = cvt_pk_bf16(o2, o3);
            *(u32x2*)(MX + orow * 1024 + 384 + d) = ow;
        }
    }
}
__device__ __forceinline__ void mixer_c_items(int l, const bf16_t* Z, bf16_t* MX, const Params& p) {
    const size_t gt = (size_t)blockIdx.x * 512 + pg8::opaque_tid(), gn = (size_t)gridDim.x * 512;
    for (size_t it = gt; it < (size_t)T_TOK * 32; it += gn) {
        const int row = (int)(it >> 5), c = (int)(it & 31) * 8;
        const bool samp = row >= TP;
        int b, t, T; if (!samp) { b = row >> 13; t = row & 8191; T = 8192; } else { const int rs = row - TP; b = rs >> 6; t = rs & 63; T = 64; }
        float cx[3][8];
#pragma unroll
        for (int k = 0; k < 3; ++k) {
            const int tt = t - 2 + k;
            if (tt >= 0) {
                const size_t ro = (size_t)(row - 2 + k) * 2304;
                const u32x4 xw = *(const u32x4*)(Z + ro + 1536 + c), gw = *(const u32x4*)(Z + ro + 2048 + c);
                cx[k][0] = bf_lo(xw.x) * bf_lo(gw.x); cx[k][1] = bf_hi(xw.x) * bf_hi(gw.x); cx[k][2] = bf_lo(xw.y) * bf_lo(gw.y); cx[k][3] = bf_hi(xw.y) * bf_hi(gw.y);
                cx[k][4] = bf_lo(xw.z) * bf_lo(gw.z); cx[k][5] = bf_hi(xw.z) * bf_hi(gw.z); cx[k][6] = bf_lo(xw.w) * bf_lo(gw.w); cx[k][7] = bf_hi(xw.w) * bf_hi(gw.w);
            } else if (samp) {
                const float* hc = p.in[3] + ((size_t)(l * 16 + b) * 2 + (2 + tt)) * 256 + c;
                const f32x4 h0 = *(const f32x4*)hc, h1 = *(const f32x4*)(hc + 4);
#pragma unroll
                for (int e = 0; e < 4; ++e) { cx[k][e] = h0[e]; cx[k][4 + e] = h1[e]; }
            } else {
#pragma unroll
                for (int e = 0; e < 8; ++e) cx[k][e] = 0.f;
            }
        }
        const u32x4 gb = *(const u32x4*)(Z + (size_t)row * 2304 + 1792 + c);
        float gbf[8]; gbf[0] = bf_lo(gb.x); gbf[1] = bf_hi(gb.x); gbf[2] = bf_lo(gb.y); gbf[3] = bf_hi(gb.y); gbf[4] = bf_lo(gb.z); gbf[5] = bf_hi(gb.z); gbf[6] = bf_lo(gb.w); gbf[7] = bf_hi(gb.w);
        float o[8];
#pragma unroll
        for (int e = 0; e < 8; ++e) o[e] = 0.f;
#pragma unroll
        for (int k = 0; k < 3; ++k) {
            const float* wk = p.in[17] + (size_t)(l * 3 + k) * 256 + c;
            const f32x4 w0 = *(const f32x4*)wk, w1 = *(const f32x4*)(wk + 4);
#pragma unroll
            for (int e = 0; e < 4; ++e) { o[e] += w0[e] * cx[k][e]; o[4 + e] += w1[e] * cx[k][4 + e]; }
        }
        u32x4 ow; ow.x = cvt_pk_bf16(gbf[0] * o[0], gbf[1] * o[1]); ow.y = cvt_pk_bf16(gbf[2] * o[2], gbf[3] * o[3]); ow.z = cvt_pk_bf16(gbf[4] * o[4], gbf[5] * o[5]); ow.w = cvt_pk_bf16(gbf[6] * o[6], gbf[7] * o[7]);
        *(u32x4*)(MX + (size_t)row * 1024 + 768 + c) = ow;
        if (t >= T - 2) {
            float* so = (samp ? p.out + O_SCS + ((size_t)(l * 16 + b) * 2 + (t - (T - 2))) * 256 : p.out + O_SCP + ((size_t)(l * 4 + b) * 2 + (t - (T - 2))) * 256) + c;
            *(f32x4*)so = (f32x4){cx[2][0], cx[2][1], cx[2][2], cx[2][3]}; *(f32x4*)(so + 4) = (f32x4){cx[2][4], cx[2][5], cx[2][6], cx[2][7]};
        }
    }
}
__device__ __forceinline__ void mixer_phase(PG8_LAS unsigned char* lds, int l, const Params& p) {
    const bf16_t* Z = (const bf16_t*)(p.ws + WS_H); bf16_t* MX = (bf16_t*)(p.ws + WS_MX); const int G = gridDim.x;
    for (int ub = blockIdx.x; ub < 264; ub += G) mixer_b_unit(lds, ub, l, Z, MX, p);
    for (int ua = G - 1 - blockIdx.x; ua < 1056; ua += G) mixer_a_unit(lds, ua, l, Z, MX, p);
    mixer_c_items(l, Z, MX, p);
    __syncthreads();
}
__device__ __forceinline__ void final_phase(const Params& p) {
    const long long* st = (const long long*)(p.ws + WS_ST + 12 * SZ_ST); const float* g = p.in[23] + 3 * 1024; const float* b = p.in[24] + 3 * 1024;
    const size_t gt = (size_t)blockIdx.x * 512 + pg8::opaque_tid(), gn = (size_t)gridDim.x * 512;
    for (size_t i = gt; i < (size_t)T_TOK * 256; i += gn) {
        const int r = (int)(i >> 8), c = (int)(i & 255) * 4; float mu, rstd; pg8::row_stats(st, r, mu, rstd);
        f32x4 v = *(const f32x4*)(p.out + (size_t)r * 1024 + c); const f32x4 gv = *(const f32x4*)(g + c), bv = *(const f32x4*)(b + c);
        v = (v - mu) * rstd * gv + bv; *(f32x4*)(p.out + (size_t)r * 1024 + c) = v;
    }
}

__global__ void __launch_bounds__(512, 2) fwd_kernel(Params p) {
    extern __shared__ __attribute__((aligned(16))) unsigned char shm[];
    PG8_LAS unsigned char* lds = (PG8_LAS unsigned char*)shm;
    unsigned char* ws = p.ws; const int G = gridDim.x;
    bf16_t* P = (bf16_t*)(ws + WS_P); bf16_t* H = (bf16_t*)(ws + WS_H); bf16_t* MX = (bf16_t*)(ws + WS_MX);
    long long* ST = (long long*)(ws + WS_ST);
    for (int ph = p.lo; ph < p.hi; ++ph) {
#ifndef NO_PREP
        if (ph == 0) prep_phase(lds, p); else
#endif
        if (ph == N_PHASES - 1) final_phase(p);
        else {
            const int l = (ph - 1) / 7, s = (ph - 1) % 7;
            if (s == 0 || s == 5) {
                const int f = s == 5, m = l * 2 + f;
                pg8::Gemm g{P, (const bf16_t*)(ws + WS_WFI + m * SZ_WFI), T_TOK, 5632, 1024}; pg8::StaticOrder S; S.init(T_TOK, 5632, G, (int)blockIdx.x);
                pg8::EpiSwiGLU E{H, ST + (size_t)(f ? 2 + 3 * l : 3 * l) * T_TOK * 2, (const float*)(ws + WS_CSF) + m * 5632, (const float*)(ws + WS_BWF) + m * 5632};
#ifndef NO_SWI
                pg8::gemm_phase<pg8::EpiSwiGLU, pg8::StaticOrder, false>(lds, g, S, E, nullptr);
#endif
            } else if (s == 1 || s == 6) {
                const int f = s == 6, m = l * 2 + f;
                pg8::Gemm g{H, (const bf16_t*)(ws + WS_WFO + m * SZ_WFO), T_TOK, 1024, 2816}; pg8::StaticOrder S; S.init(T_TOK, 1024, G, (int)blockIdx.x);
                const float* go = f ? p.in[19] + l * 1024 : (l ? p.in[23] + (l - 1) * 1024 : (const float*)(ws + WS_ONE));
                const float* bo = f ? p.in[20] + l * 1024 : (l ? p.in[24] + (l - 1) * 1024 : (const float*)(ws + WS_ZERO));
                pg8::EpiRes E{P, (f && l == NL - 1) ? p.out : nullptr, ST + (size_t)(f ? 2 + 3 * l : 3 * l) * T_TOK * 2, go, bo, ST + (size_t)(f ? 3 + 3 * l : 1 + 3 * l) * T_TOK * 2, 0.5f};
#ifndef NO_RES
                pg8::gemm_phase<pg8::EpiRes, pg8::StaticOrder, false>(lds, g, S, E, nullptr);
#endif
            } else if (s == 2) {
                pg8::Gemm g{P, (const bf16_t*)(ws + WS_WI + l * SZ_WI), T_TOK, 2304, 1024}; pg8::StaticOrder S; S.init(T_TOK, 2304, G, (int)blockIdx.x);
                pg8::EpiZ E{H, ST + (size_t)(1 + 3 * l) * T_TOK * 2, (const float*)(ws + WS_CSI) + l * 2304, (const float*)(ws + WS_BWI) + l * 2304};
#ifndef NO_Z
                pg8::gemm_phase<pg8::EpiZ, pg8::StaticOrder, false>(lds, g, S, E, nullptr);
#endif
            } else if (s == 3) {
#ifndef NO_MIX
                mixer_phase(lds, l, p);
#endif
            } else {
                pg8::Gemm g{MX, (const bf16_t*)(ws + WS_WO + l * SZ_WO), T_TOK, 1024, 1024}; pg8::StaticOrder S; S.init(T_TOK, 1024, G, (int)blockIdx.x);
                pg8::EpiRes E{P, nullptr, ST + (size_t)(1 + 3 * l) * T_TOK * 2, p.in[6] + l * 1024, p.in[7] + l * 1024, ST + (size_t)(2 + 3 * l) * T_TOK * 2, 1.0f};
#ifndef NO_RES
                pg8::gemm_phase<pg8::EpiRes, pg8::StaticOrder, false>(lds, g, S, E, nullptr);
#endif
            }
        }
        if (ph + 1 < p.hi) { cg::this_grid().sync(); }
    }
}

#ifndef N_LAUNCH_MODE
#define N_LAUNCH_MODE 0
#endif
extern "C" void kernel_launch(void* const* d_in, const int* in_sizes, int n_in, void* d_out, int out_size, void* d_ws, size_t ws_size, hipStream_t stream) {
    static int grid = 0;
    if (grid == 0) {
        if (n_in != 25 || ws_size < WS_END) { fprintf(stderr, "kernel_launch: need 25 inputs and %zu bytes of workspace; got %d, %zu\n", (size_t)WS_END, n_in, ws_size); grid = -1; return; }
        int dev = 0, cus = 0, per_cu = 0;
        hipGetDevice(&dev); hipDeviceGetAttribute(&cus, hipDeviceAttributeMultiprocessorCount, dev);
        if (hipFuncSetAttribute((const void*)fwd_kernel, hipFuncAttributeMaxDynamicSharedMemorySize, LDS_BYTES) != hipSuccess) { fprintf(stderr, "kernel_launch: hipFuncSetAttribute failed\n"); grid = -1; return; }
        if (hipOccupancyMaxActiveBlocksPerMultiprocessor(&per_cu, (const void*)fwd_kernel, 512, LDS_BYTES) != hipSuccess || per_cu < 1) { fprintf(stderr, "kernel_launch: occupancy query says %d\n", per_cu); per_cu = 1; }
        (void)hipGetLastError();
        grid = cus * per_cu;
        fprintf(stderr, "kernel_launch: grid %d (cus %d x %d)\n", grid, cus, per_cu);
    }
    if (grid < 0) return;
    Params p{};
    for (int i = 0; i < 25; ++i) p.in[i] = (const float*)d_in[i];
    p.out = (float*)d_out; p.ws = (unsigned char*)d_ws;
#if N_LAUNCH_MODE == 1
    p.lo = 0; p.hi = N_PHASES;
    void* args[] = {&p};
    hipError_t e = hipLaunchCooperativeKernel((const void*)fwd_kernel, dim3(grid), dim3(512), args, LDS_BYTES, stream);
    if (e != hipSuccess) fprintf(stderr, "cooperative launch failed: %s (grid %d)\n", hipGetErrorString(e), grid);
#else
    for (int ph = 0; ph < N_PHASES; ++ph) {
        p.lo = ph; p.hi = ph + 1;
        hipLaunchKernelGGL(fwd_kernel, dim3(grid), dim3(512), LDS_BYTES, stream, p);
    }
#endif
}
```

```cpp
#include <hip/hip_runtime.h>
#include <hip/hip_cooperative_groups.h>
#include <cstdio>
namespace cg = cooperative_groups;
#ifndef F8_MASK_VALUE
#define F8_MASK_VALUE 0xE0u
#endif
#ifndef F8O_MASK_VALUE
#define F8O_MASK_VALUE 0xFFu
#endif
namespace pg8 {
__device__ __forceinline__ float shx(float v, int o, int lane) { return __int_as_float(__builtin_amdgcn_ds_bpermute((lane ^ o) << 2, __float_as_int(v))); }
__device__ __forceinline__ int opaque_tid() { int t = threadIdx.x; asm volatile("" : "+v"(t)); return t; }
#define PG8_LAS __attribute__((address_space(3)))
typedef unsigned short bf16_t;
typedef short bf16x8 __attribute__((ext_vector_type(8)));
typedef float f32x4 __attribute__((ext_vector_type(4)));
typedef unsigned u32x4 __attribute__((ext_vector_type(4)));
constexpr int BM = 256, BK = 64, HALF = 128, HTB = HALF * BK * 2  , STAGE_BYTES = 8 * HTB, NXCD = 8, WGM = 8;

__host__ __device__ __forceinline__ int lds_byte(int r, int c) { const int st = (r >> 4) * 2 + (c >> 5), rr = r & 15, cc = c & 31, ob = rr * 64 + cc * 2; return st * 1024 + (ob ^ (((ob >> 9) & 1) << 5)); }
__host__ __device__ __forceinline__ void stage_rc(int b, int& R, int& C) { const int st = b / 1024, sb = b % 1024, swz = sb ^ (((sb >> 9) & 1) << 5); R = (st >> 1) * 16 + swz / 64; C = (st & 1) * 32 + (swz % 64) / 2; }
__host__ __device__ __forceinline__ int perm32(int rho) { const int n = rho >> 4, i = rho & 15; return 8 * (i >> 2) + 4 * n + (i & 3); }

struct Unit { int pm, pn, fresh; };
struct Gemm { const bf16_t* A; const bf16_t* Bt; int M, N, K, ld; };

struct StaticOrder {
    int nM, nN, nwg, G, c;
    __host__ __device__ void init(int M, int N, int G_, int c_) { nM = M / BM; nN = N / BM; nwg = nM * nN; G = G_; c = c_; }
    __host__ __device__ bool next(int i, Unit& u) const {
        const long L = (long)i * G + c; if (L >= nwg) return false;
        int wgid = (int)L; { const int q = nwg / NXCD, r = nwg % NXCD, xcd = wgid % NXCD, off = wgid / NXCD; wgid = (xcd < r ? xcd * (q + 1) : r * (q + 1) + (xcd - r) * q) + off; }
        const int nig = WGM * nN, gid = wgid / nig, fm = gid * WGM, gsz = (nM - fm) < WGM ? (nM - fm) : WGM;
        u.pm = fm + ((wgid % nig) % gsz); u.pn = (wgid % nig) / gsz; return true;
    }
    __device__ __forceinline__ void a_ready(const Unit&) const {}
    __device__ __forceinline__ void done(const Unit&) const {}
};

__device__ __forceinline__ unsigned cvt_pk_bf16(float lo, float hi) { unsigned r; asm volatile("v_cvt_pk_bf16_f32 %0, %1, %2" : "=v"(r) : "v"(lo), "v"(hi)); return r; }
__device__ __forceinline__ float bf_lo(unsigned w) { return __uint_as_float(w << 16); }
__device__ __forceinline__ float bf_hi(unsigned w) { return __uint_as_float(w & 0xffff0000u); }
typedef unsigned u32x2v __attribute__((ext_vector_type(2)));
typedef int i32x8 __attribute__((ext_vector_type(8)));
typedef int i32x4v __attribute__((ext_vector_type(4)));
__device__ __forceinline__ unsigned f8x4(float a, float b, float c, float d) {
    a = __builtin_fminf(__builtin_fmaxf(a, -448.f), 448.f); b = __builtin_fminf(__builtin_fmaxf(b, -448.f), 448.f); c = __builtin_fminf(__builtin_fmaxf(c, -448.f), 448.f); d = __builtin_fminf(__builtin_fmaxf(d, -448.f), 448.f);
    int r = __builtin_amdgcn_cvt_pk_fp8_f32(a, b, 0, false); r = __builtin_amdgcn_cvt_pk_fp8_f32(c, d, r, true); return (unsigned)r; }
constexpr unsigned F8_MASK = F8_MASK_VALUE;
__host__ __device__ constexpr bool is_f8(int m) { return (F8_MASK >> m) & 1u; }
constexpr unsigned F8O_MASK = F8O_MASK_VALUE;
__host__ __device__ constexpr bool is_f8o(int m) { return (F8O_MASK >> m) & 1u; }
constexpr float F8_HSCALE = 4.0f, F8_WOSCALE = 256.0f;
constexpr float F8_WSCALE = 64.0f;
constexpr float LN_EPS_F = 1e-5f;
constexpr float ALPHA_F = 1.6817928305074290f;
typedef float f32x2 __attribute__((ext_vector_type(2)));
__device__ __forceinline__ void stats_of(const f32x4 a, const f32x4 b, float& mu, float& rstd) {
    const float sx = (a[0] + a[2]) + (b[0] + b[2]), sy = (a[1] + a[3]) + (b[1] + b[3]);
    mu = sx * (1.0f / 1024.0f); const float var = sy * (1.0f / 1024.0f) - mu * mu; rstd = rsqrtf(var + LN_EPS_F);
}
__device__ __forceinline__ void row_stats(const float* st, int r, float& mu, float& rstd) {
    const f32x4 a = *(const f32x4*)(st + 8 * (size_t)r), b = *(const f32x4*)(st + 8 * (size_t)r + 4); stats_of(a, b, mu, rstd);
}
__device__ __forceinline__ void stats_tab_fill(PG8_LAS unsigned char* scr, const float* st, const Unit& u, int wr, int wc, int fr, int fq) {
    if (u.fresh) {
        const int lane = fq * 16 + fr;
        if (lane < 32) { const int ri = wc * 32 + lane, r = u.pm * BM + (ri >> 6) * HALF + wr * 64 + (ri & 63); float mu, rstd; row_stats(st, r, mu, rstd);
            *(PG8_LAS f32x2*)(scr + (wr * 128 + ri) * 8) = (f32x2){mu, rstd}; }
        asm volatile("s_waitcnt lgkmcnt(0)" ::: "memory"); __builtin_amdgcn_s_barrier(); asm volatile("" ::: "memory");
    }
}
__device__ __forceinline__ float silu_f(float g) { return g * __builtin_amdgcn_rcpf(1.0f + __expf(-g)); }
__device__ __forceinline__ float sigmoid_f(float g) { return __builtin_amdgcn_rcpf(1.0f + __expf(-g)); }

struct EpiSwiGLU {
    static constexpr bool PERM = true, AFTER_DRAIN = false;
    bf16_t* H; const float* st; const float* cs; const float* bw; float ascale; float hscale; PG8_LAS unsigned char* scr;
    __device__ __forceinline__ void operator()(const f32x4 (&acc)[2][2][4][2], const Unit& u, int wr, int wc, int fr, int fq) const {
        const int row0 = u.pm * BM + wr * 64 + fr;
        stats_tab_fill(scr, st, u, wr, wc, fr, fq);
        const int nb = u.pn * BM + wc * 32 + 8 * fq;
        const int hc = u.pn * 128 + wc * 32 + 8 * fq;
        f32x4 csg[2], bwg[2], csu[2], bwu[2];
#pragma unroll
        for (int n = 0; n < 2; ++n) { csg[n] = *(const f32x4*)(cs + nb + 4 * n); bwg[n] = *(const f32x4*)(bw + nb + 4 * n); csu[n] = *(const f32x4*)(cs + nb + 128 + 4 * n); bwu[n] = *(const f32x4*)(bw + nb + 128 + 4 * n); }
#pragma unroll
        for (int ai = 0; ai < 2; ++ai)
#pragma unroll
            for (int m = 0; m < 4; ++m) {
                const int r = row0 + ai * HALF + m * 16; const f32x2 mr_ = *(const PG8_LAS f32x2*)(scr + (wr * 128 + ai * 64 + m * 16 + fr) * 8); const float mu = mr_[0], rstd = mr_[1];
                float h[8];
#pragma unroll
                for (int n = 0; n < 2; ++n) {
                    const f32x4 g = (acc[ai][0][m][n] * ascale - mu * csg[n]) * rstd + bwg[n];
                    const f32x4 up = (acc[ai][1][m][n] * ascale - mu * csu[n]) * rstd + bwu[n];
                    const f32x4 t = g * (-1.4426950408889634f); f32x4 e;
#pragma unroll
                    for (int j = 0; j < 4; ++j) e[j] = __builtin_amdgcn_exp2f(t[j]);
                    const f32x4 d = e + 1.0f; f32x4 rc;
#pragma unroll
                    for (int j = 0; j < 4; ++j) rc[j] = __builtin_amdgcn_rcpf(d[j]);
                    const f32x4 o = (g * up) * rc;
#pragma unroll
                    for (int j = 0; j < 4; ++j) h[4 * n + j] = o[j];
                }
                if (hscale != 0.f) {
                    *(u32x2v*)((unsigned char*)H + (size_t)r * 2816 + hc) = (u32x2v){f8x4(h[0] * hscale, h[1] * hscale, h[2] * hscale, h[3] * hscale), f8x4(h[4] * hscale, h[5] * hscale, h[6] * hscale, h[7] * hscale)};
                } else {
                u32x4 w; w.x = cvt_pk_bf16(h[0], h[1]); w.y = cvt_pk_bf16(h[2], h[3]); w.z = cvt_pk_bf16(h[4], h[5]); w.w = cvt_pk_bf16(h[6], h[7]);
                *(u32x4*)(H + (size_t)r * 2816 + hc) = w;
                }
            }
    }
};
struct EpiNone { static constexpr bool PERM = true, AFTER_DRAIN = false; float* sink;
    __device__ __forceinline__ void operator()(const f32x4 (&acc)[2][2][4][2], const Unit& u, int wr, int wc, int fr, int fq) const {
        float t = 0.f;
#pragma unroll
        for (int ai = 0; ai < 2; ++ai)
#pragma unroll
            for (int bj = 0; bj < 2; ++bj)
#pragma unroll
                for (int m = 0; m < 4; ++m)
#pragma unroll
                    for (int n = 0; n < 2; ++n) t += acc[ai][bj][m][n][0] + acc[ai][bj][m][n][1] + acc[ai][bj][m][n][2] + acc[ai][bj][m][n][3];
        if (t == 123.456f) sink[0] = t; } };
struct EpiPart {
    static constexpr bool PERM = true, AFTER_DRAIN = false;
    bf16_t* part;
    __device__ __forceinline__ void operator()(const f32x4 (&acc)[2][2][4][2], const Unit& u, int wr, int wc, int fr, int fq) const {
        const int row0 = u.pm * BM + wr * 64 + fr, c0 = u.pn * BM + wc * 32 + 8 * fq;
#pragma unroll
        for (int ai = 0; ai < 2; ++ai)
#pragma unroll
            for (int m = 0; m < 4; ++m)
#pragma unroll
                for (int bj = 0; bj < 2; ++bj) { const f32x4 v0 = acc[ai][bj][m][0], v1 = acc[ai][bj][m][1];
                    u32x4 w; w.x = cvt_pk_bf16(v0[0], v0[1]); w.y = cvt_pk_bf16(v0[2], v0[3]); w.z = cvt_pk_bf16(v1[0], v1[1]); w.w = cvt_pk_bf16(v1[2], v1[3]);
                    *(u32x4*)((char*)part + (unsigned)((row0 + ai * HALF + m * 16) * 2048 + (c0 + bj * HALF) * 2)) = w; }
    }
};
struct SingleUnit { int pm, pn;
    __device__ __forceinline__ bool next(int i, Unit& u) const { if (i != 0) return false; u.pm = pm; u.pn = pn; return true; }
    __device__ __forceinline__ void a_ready(const Unit&) const {}
    __device__ __forceinline__ void done(const Unit&) const {}
};
struct EpiZ {
    static constexpr bool PERM = true, AFTER_DRAIN = false;
    bf16_t* Z; const float* st; const float* cs; const float* bw; PG8_LAS unsigned char* scr;
    __device__ __forceinline__ void operator()(const f32x4 (&acc)[2][2][4][2], const Unit& u, int wr, int wc, int fr, int fq) const {
        const int row0 = u.pm * BM + wr * 64 + fr;
        stats_tab_fill(scr, st, u, wr, wc, fr, fq);
        const int c0 = u.pn * BM + wc * 32 + 8 * fq;
        f32x4 csv[2][2], bwv[2][2];
#pragma unroll
        for (int bj = 0; bj < 2; ++bj)
#pragma unroll
            for (int n = 0; n < 2; ++n) { csv[bj][n] = *(const f32x4*)(cs + c0 + bj * HALF + 4 * n); bwv[bj][n] = *(const f32x4*)(bw + c0 + bj * HALF + 4 * n); }
#pragma unroll
        for (int ai = 0; ai < 2; ++ai)
#pragma unroll
            for (int m = 0; m < 4; ++m) {
                const int r = row0 + ai * HALF + m * 16; const f32x2 mr_ = *(const PG8_LAS f32x2*)(scr + (wr * 128 + ai * 64 + m * 16 + fr) * 8); const float mu = mr_[0], rstd = mr_[1];
#pragma unroll
                for (int bj = 0; bj < 2; ++bj) {
                    const f32x4 v0 = (acc[ai][bj][m][0] - mu * csv[bj][0]) * rstd + bwv[bj][0];
                    const f32x4 v1 = (acc[ai][bj][m][1] - mu * csv[bj][1]) * rstd + bwv[bj][1];
                    u32x4 w; w.x = cvt_pk_bf16(v0[0], v0[1]); w.y = cvt_pk_bf16(v0[2], v0[3]); w.z = cvt_pk_bf16(v1[0], v1[1]); w.w = cvt_pk_bf16(v1[2], v1[3]);
                    *(u32x4*)(Z + (size_t)r * 2304 + c0 + bj * HALF) = w;
                }
            }
    }
};
struct EpiRes {
    static constexpr bool PERM = true, AFTER_DRAIN = false;
    bf16_t* P; unsigned char* P8; const float* st_old; const float* g; const float* b; float* st_new; float scale; PG8_LAS unsigned char* scr;
    __device__ __forceinline__ void operator()(const f32x4 (&acc)[2][2][4][2], const Unit& u, int wr, int wc, int fr, int fq) const {
        const int row0 = u.pm * BM + wr * 64 + fr;
        const int c0 = u.pn * BM + wc * 32 + 8 * fq;
        f32x4 gv[2][2], bv[2][2];
#pragma unroll
        for (int bj = 0; bj < 2; ++bj)
#pragma unroll
            for (int n = 0; n < 2; ++n) { gv[bj][n] = *(const f32x4*)(g + c0 + bj * HALF + 4 * n); bv[bj][n] = *(const f32x4*)(b + c0 + bj * HALF + 4 * n) * ALPHA_F; }
#pragma unroll
        for (int hh = 0; hh < 4; ++hh) {
            const int ai = hh >> 1;
            u32x4 pw[4][2]; f32x4 sva[4], svb[4];
#pragma unroll
            for (int m = (hh & 1) * 2; m < (hh & 1) * 2 + 2; ++m) { const int r = row0 + ai * HALF + m * 16; sva[m] = *(const f32x4*)((const char*)st_old + (unsigned)(r * 32)); svb[m] = *(const f32x4*)((const char*)st_old + (unsigned)(r * 32 + 16));
#pragma unroll
                for (int bj = 0; bj < 2; ++bj) pw[m][bj] = *(const u32x4*)((const char*)P + (unsigned)(r * 2048 + (c0 + bj * HALF) * 2)); }
#pragma unroll
            for (int m = (hh & 1) * 2; m < (hh & 1) * 2 + 2; ++m) {
                const int r = row0 + ai * HALF + m * 16;
                float mu, rs; stats_of(sva[m], svb[m], mu, rs); rs *= ALPHA_F;
                float s = 0.f, ss = 0.f;
#pragma unroll
                for (int bj = 0; bj < 2; ++bj) {
                    const int c = c0 + bj * HALF; const u32x4 w0 = pw[m][bj];
                    f32x4 x0, x1;
                    x0[0] = bf_lo(w0.x); x0[1] = bf_hi(w0.x); x0[2] = bf_lo(w0.y); x0[3] = bf_hi(w0.y);
                    x1[0] = bf_lo(w0.z); x1[1] = bf_hi(w0.z); x1[2] = bf_lo(w0.w); x1[3] = bf_hi(w0.w);
                    f32x4 v0 = ((x0 - mu) * rs) * gv[bj][0] + (bv[bj][0] + scale * acc[ai][bj][m][0]);
                    f32x4 v1 = ((x1 - mu) * rs) * gv[bj][1] + (bv[bj][1] + scale * acc[ai][bj][m][1]);
                    {
                        u32x4 w; w.x = cvt_pk_bf16(v0[0], v0[1]); w.y = cvt_pk_bf16(v0[2], v0[3]); w.z = cvt_pk_bf16(v1[0], v1[1]); w.w = cvt_pk_bf16(v1[2], v1[3]);
                        *(u32x4*)((char*)P + (unsigned)(r * 2048 + c * 2)) = w;
                        if (P8) *(u32x2v*)(P8 + (unsigned)(r * 1024 + c)) = (u32x2v){f8x4(v0[0], v0[1], v0[2], v0[3]), f8x4(v1[0], v1[1], v1[2], v1[3])};
                        v0[0] = bf_lo(w.x); v0[1] = bf_hi(w.x); v0[2] = bf_lo(w.y); v0[3] = bf_hi(w.y);
                        v1[0] = bf_lo(w.z); v1[1] = bf_hi(w.z); v1[2] = bf_lo(w.w); v1[3] = bf_hi(w.w);
                    }
                    s += (v0[0] + v0[1]) + (v0[2] + v0[3]) + (v1[0] + v1[1]) + (v1[2] + v1[3]);
                    ss += (v0[0] * v0[0] + v0[1] * v0[1]) + (v0[2] * v0[2] + v0[3] * v0[3]) + (v1[0] * v1[0] + v1[1] * v1[1]) + (v1[2] * v1[2] + v1[3] * v1[3]);
                }
                { const int ln = fq * 16 + fr; s += shx(s, 16, ln); s += shx(s, 32, ln); ss += shx(ss, 16, ln); ss += shx(ss, 32, ln); }
                if (fq == 0) *(PG8_LAS f32x2*)(scr + (((wr * 4 + wc) * 128) + ai * 64 + m * 16 + fr) * 8) = (f32x2){s, ss};
            }
            asm volatile("" ::: "memory");
        }
        asm volatile("s_waitcnt lgkmcnt(0)" ::: "memory"); __builtin_amdgcn_s_barrier(); asm volatile("" ::: "memory");
        const int lane = fq * 16 + fr;
        if (lane < 32) {
            const int ri = wc * 32 + lane;
            const PG8_LAS unsigned char* q = scr + (wr * 4 * 128 + ri) * 8;
            const f32x2 p0 = *(const PG8_LAS f32x2*)q, p1 = *(const PG8_LAS f32x2*)(q + 1024), p2 = *(const PG8_LAS f32x2*)(q + 2048), p3 = *(const PG8_LAS f32x2*)(q + 3072);
            const int r = u.pm * BM + (ri >> 6) * HALF + wr * 64 + (ri & 63);
            *(f32x2*)((char*)st_new + (unsigned)(r * 32 + 8 * u.pn)) = (f32x2){(p0[0] + p1[0]) + (p2[0] + p3[0]), (p0[1] + p1[1]) + (p2[1] + p3[1])};
        }
    }
};

template <class Epi, class Sched, bool STAMP = false, bool F8 = false>
__device__ __forceinline__ void gemm_phase(PG8_LAS unsigned char* lds, const Gemm g, const Sched& S, const Epi& E, unsigned long long* stamps) {
    const int tid = opaque_tid(), wid = __builtin_amdgcn_readfirstlane(tid >> 6), lane = tid & 63, wr = wid >> 2, wc = wid & 3, fr = lane & 15, fq = lane >> 4;
    const int K = g.ld, nt = g.K / BK;
    int ts_lo = 0, ts_hi = 0, nts = 0; const unsigned long long rt_entry = STAMP ? (unsigned long long)wall_clock64() : 0ull;
#define PG8_STAMP() do { if (STAMP && wid == 0 && nts < 64) { const unsigned long long _c = (unsigned long long)clock64(); \
        ts_lo = (lane == nts) ? (int)(unsigned)_c : ts_lo; ts_hi = (lane == nts) ? (int)(unsigned)(_c >> 32) : ts_hi; ++nts; } } while (0)
    PG8_STAMP();
    unsigned voffA[2], voffB[2];
#pragma unroll
    for (int i = 0; i < 2; ++i) { int R, C; stage_rc(tid * 16 + i * 8192, R, C); const int Rb = Epi::PERM ? ((R & ~31) + perm32(R & 31)) : R;
        voffA[i] = (unsigned)(R * K + C) * 2u; voffB[i] = (unsigned)(Rb * K + C) * 2u; }
    const size_t kstep = (size_t)(BK * 2);
    const size_t hstep = (size_t)HALF * K * 2;
    const size_t tstep = 2 * hstep;
    const unsigned ldsw = (unsigned)wid * 1024u;
    const int aoff = lds_byte(wr * 64 + fr, fq * 8), boff = lds_byte(wc * 32 + fr, fq * 8);
#define PG8_SA(b, h) (((b) * 2 + (h)) * HTB)
#define PG8_SB(b, h) ((4 + (b) * 2 + (h)) * HTB)
#define PG8_STAGE(bufoff, gbase, voff) do { _Pragma("unroll") for (int _i = 0; _i < 2; ++_i) \
        __builtin_amdgcn_global_load_lds((const unsigned*)((const char*)(gbase) + (voff)[_i]), (PG8_LAS unsigned*)(lds + (bufoff) + ldsw + _i * 8192), 16, 0, 0); } while (0)
#define PG8_LDA(dst, b, h) do { _Pragma("unroll") for (int m = 0; m < 4; ++m) { if constexpr (F8) { \
            const i32x4v lo_ = *(const PG8_LAS i32x4v*)(lds + PG8_SA(b, h) + aoff + m * 2048), hi_ = *(const PG8_LAS i32x4v*)(lds + PG8_SA(b, h) + aoff + m * 2048 + 1024); \
            dst##8[m] = __builtin_shufflevector(lo_, hi_, 0, 1, 2, 3, 4, 5, 6, 7); } else { \
        _Pragma("unroll") for (int k = 0; k < 2; ++k) dst[m][k] = *(const PG8_LAS bf16x8*)(lds + PG8_SA(b, h) + aoff + m * 2048 + k * 1024); } } } while (0)
#define PG8_LDB(dst, b, h) do { _Pragma("unroll") for (int n = 0; n < 2; ++n) { if constexpr (F8) { \
            const i32x4v lo_ = *(const PG8_LAS i32x4v*)(lds + PG8_SB(b, h) + boff + n * 2048), hi_ = *(const PG8_LAS i32x4v*)(lds + PG8_SB(b, h) + boff + n * 2048 + 1024); \
            dst##8[n] = __builtin_shufflevector(lo_, hi_, 0, 1, 2, 3, 4, 5, 6, 7); } else { \
        _Pragma("unroll") for (int k = 0; k < 2; ++k) dst[n][k] = *(const PG8_LAS bf16x8*)(lds + PG8_SB(b, h) + boff + n * 2048 + k * 1024); } } } while (0)
#define PG8_MMA(ai, bj, At, Bt) do { __builtin_amdgcn_s_setprio(1); _Pragma("unroll") for (int m = 0; m < 4; ++m) _Pragma("unroll") for (int n = 0; n < 2; ++n) { \
        if constexpr (F8) {   \
            asm volatile("v_mfma_scale_f32_16x16x128_f8f6f4 %0, %1, %2, %0, %3, %3 op_sel_hi:[0,0,0]" : "+v"(acc[ai][bj][m][n]) : "v"(Bt##8[n]), "v"(At##8[m]), "v"(f8sc));   \
        } else { _Pragma("unroll") for (int k = 0; k < 2; ++k) \
        acc[ai][bj][m][n] = __builtin_amdgcn_mfma_f32_16x16x32_bf16(Bt[n][k], At[m][k], acc[ai][bj][m][n], 0, 0, 0); } } __builtin_amdgcn_s_setprio(0); } while (0)
#define PG8_WAIT_V(n) asm volatile("s_waitcnt vmcnt(" #n ")" ::: "memory")
#define PG8_WAIT_L(n) asm volatile("s_waitcnt lgkmcnt(" #n ")" ::: "memory")
#define PG8_BAR __builtin_amdgcn_s_barrier()
#define PG8_SCHED __builtin_amdgcn_sched_barrier(0)
    Unit cur, nxt; int ui = 0; int prevpm = -1;
    if (!S.next(0, cur)) return;
    f32x4 acc[2][2][4][2];
#pragma unroll
    for (int a = 0; a < 2; ++a)
#pragma unroll
        for (int b = 0; b < 2; ++b)
#pragma unroll
            for (int m = 0; m < 4; ++m)
#pragma unroll
                for (int n = 0; n < 2; ++n) acc[a][b][m][n] = (f32x4){0.f, 0.f, 0.f, 0.f};
    const int f8sc = 0x7F7F7F7F;
    bf16x8 At[4][2], B0[2][2], B1[2][2]; i32x8 At8[4], B08[2], B18[2];
    const char* cA = (const char*)g.A + (size_t)cur.pm * tstep; const char* cB = (const char*)g.Bt + (size_t)cur.pn * tstep;
    S.a_ready(cur);
    PG8_STAGE(PG8_SB(0, 0), cB, voffB); PG8_STAGE(PG8_SA(0, 0), cA, voffA); PG8_STAGE(PG8_SB(0, 1), cB + hstep, voffB); PG8_STAGE(PG8_SA(0, 1), cA + hstep, voffA);
    if (wr == 1) PG8_BAR;
    PG8_WAIT_V(4); PG8_BAR;
    PG8_STAGE(PG8_SB(1, 0), cB + kstep, voffB); PG8_STAGE(PG8_SA(1, 0), cA + kstep, voffA); PG8_STAGE(PG8_SB(1, 1), cB + hstep + kstep, voffB);
    PG8_WAIT_V(6); PG8_BAR;
    PG8_STAMP();
    for (;;) {
        const bool has_next = S.next(ui + 1, nxt);
        const char* nA = has_next ? (const char*)g.A + (size_t)nxt.pm * tstep : cA; const char* nB = has_next ? (const char*)g.Bt + (size_t)nxt.pn * tstep : cB;
        for (int t = 0; t < nt; t += 2) {
            const bool last = (t == nt - 2);
            const char* a1 = cA + (size_t)(t + 1) * kstep;
            const char* a2 = last ? nA : cA + (size_t)(t + 2) * kstep; const char* b2 = last ? nB : cB + (size_t)(t + 2) * kstep;
            const char* a3 = a2 + kstep; const char* b3 = b2 + kstep;
            if (last && has_next) S.a_ready(nxt);
            PG8_LDB(B0, 0, 0); PG8_SCHED; PG8_LDA(At, 0, 0); PG8_STAGE(PG8_SA(1, 1), a1 + hstep, voffA);
            PG8_WAIT_L(8); PG8_BAR; PG8_WAIT_L(0); PG8_MMA(0, 0, At, B0); PG8_BAR; PG8_SCHED;
            PG8_LDB(B1, 0, 1); PG8_STAGE(PG8_SB(0, 0), b2, voffB);
            PG8_WAIT_V(10); PG8_BAR; PG8_WAIT_L(0); PG8_MMA(0, 1, At, B1); PG8_BAR;
            PG8_LDA(At, 0, 1); PG8_STAGE(PG8_SA(0, 0), a2, voffA);
            PG8_BAR; PG8_WAIT_L(0); PG8_MMA(1, 0, At, B0); PG8_BAR; PG8_SCHED;
            PG8_STAGE(PG8_SB(0, 1), b2 + hstep, voffB);
            PG8_WAIT_V(8); PG8_BAR; PG8_MMA(1, 1, At, B1); PG8_BAR;
            PG8_LDB(B0, 1, 0); PG8_SCHED; PG8_LDA(At, 1, 0); PG8_STAGE(PG8_SA(0, 1), a2 + hstep, voffA);
            PG8_WAIT_L(8); PG8_BAR; PG8_WAIT_L(0); PG8_MMA(0, 0, At, B0); PG8_BAR; PG8_SCHED;
            PG8_LDB(B1, 1, 1); PG8_STAGE(PG8_SB(1, 0), b3, voffB);
            PG8_WAIT_V(10); PG8_BAR; PG8_WAIT_L(0); PG8_MMA(0, 1, At, B1); PG8_BAR;
            PG8_LDA(At, 1, 1); PG8_STAGE(PG8_SA(1, 0), a3, voffA);
            PG8_BAR; PG8_WAIT_L(0); PG8_MMA(1, 0, At, B0); PG8_BAR; PG8_SCHED;
            PG8_STAGE(PG8_SB(1, 1), b3 + hstep, voffB);
            PG8_WAIT_V(8); PG8_BAR; PG8_MMA(1, 1, At, B1); PG8_BAR;
        }
        PG8_STAMP();
        if constexpr (F8) asm volatile("s_nop 15\n\ts_nop 15" ::: "memory");
        cur.fresh = (cur.pm != prevpm); prevpm = cur.pm;
        if constexpr (!Epi::AFTER_DRAIN) { E(acc, cur, wr, wc, fr, fq); S.done(cur); }
        PG8_STAMP();
        if (!has_next) break;
#pragma unroll
        for (int a = 0; a < 2; ++a)
#pragma unroll
            for (int b = 0; b < 2; ++b)
#pragma unroll
                for (int m = 0; m < 4; ++m)
#pragma unroll
                    for (int n = 0; n < 2; ++n) acc[a][b][m][n] = (f32x4){0.f, 0.f, 0.f, 0.f};
        cur = nxt; cA = nA; cB = nB; ++ui;
    }
    PG8_WAIT_V(0);
    if (wr == 0) PG8_BAR;
    PG8_BAR;
    if constexpr (Epi::AFTER_DRAIN) { E.fused(acc, cur, wr, wc, fr, fq, lds, wid, lane); S.done(cur); }
    PG8_STAMP();
    if (STAMP && wid == 0) { stamps[lane] = lane < nts ? (((unsigned long long)(unsigned)ts_hi << 32) | (unsigned)ts_lo) : 0ull;
        if (lane == 62) stamps[62] = rt_entry; if (lane == 63) stamps[63] = (unsigned long long)wall_clock64(); }
#undef PG8_STAMP
#undef PG8_SA
#undef PG8_SB
#undef PG8_STAGE
#undef PG8_LDA
#undef PG8_LDB
#undef PG8_MMA
#undef PG8_WAIT_V
#undef PG8_WAIT_L
#undef PG8_BAR
#undef PG8_SCHED
}
}

#define XB_TMO      128
#define XB_XCNT(j)  (256  + 64 * (j))
#define XB_XSUB(j)  (1280 + 64 * (j))
#define XB_XGEN(j)  (2304 + 64 * (j))
#define XB_TOP      3328
#define XB_TOPGEN   3392
#define XCD_BAR_WORDS 3456
#define XB_SPIN_CAP (1u << 18)
#define LAS __attribute__((address_space(3)))

__device__ __forceinline__ unsigned xb_ld(unsigned* p)              { return __hip_atomic_load(p, __ATOMIC_RELAXED, __HIP_MEMORY_SCOPE_AGENT); }
__device__ __forceinline__ unsigned xb_add(unsigned* p, unsigned v) { return __hip_atomic_fetch_add(p, v, __ATOMIC_RELAXED, __HIP_MEMORY_SCOPE_AGENT); }
__device__ __forceinline__ unsigned xb_xcc_id() { return (unsigned)__builtin_amdgcn_s_getreg((3 << 11) | 20) & 0xFu; }
#define XB_SPIN(cond, bar) do { unsigned _sp = 0; while (cond) { __builtin_amdgcn_s_sleep(1); \
    if ((++_sp & 255u) == 0u) { if (xb_ld(&(bar)[XB_TMO])) break; if (_sp > XB_SPIN_CAP) { atomicAdd(&(bar)[XB_TMO], 1u); break; } } } } while (0)

struct XcdBarrier {
    unsigned* bar; unsigned x;
    volatile LAS unsigned* st;
};

__device__ __forceinline__ XcdBarrier xcd_barrier_post(unsigned* bar, volatile LAS unsigned* st) {
    XcdBarrier b; b.bar = bar; b.x = xb_xcc_id(); b.st = st;
    if (threadIdx.x == 0) (void)xb_add(&bar[XB_XCNT(b.x)], 1u);
    return b;
}
__device__ __forceinline__ void xcd_barrier_complete(unsigned* bar, unsigned x, unsigned& nloc, unsigned& nx) {
    const unsigned G = gridDim.x * gridDim.y * gridDim.z;
    unsigned sum, cnt, mine, sp = 0u;
    for (;;) {
        sum = 0u; cnt = 0u; mine = 0u;
#pragma unroll
        for (unsigned j = 0; j < 16; ++j) { const unsigned c = xb_ld(&bar[XB_XCNT(j)]); sum += c; cnt += (c > 0u) ? 1u : 0u; mine = (j == x) ? c : mine; }
        if (sum == G) break;
        __builtin_amdgcn_s_sleep(1);
        if ((++sp & 255u) == 0u) { if (xb_ld(&bar[XB_TMO])) break; if (sp > XB_SPIN_CAP) { atomicAdd(&bar[XB_TMO], 1u); break; } }
    }
    nloc = mine > 0u ? mine : 1u; nx = cnt > 0u ? cnt : 1u;
}

__device__ __forceinline__ void xcd_barrier(const XcdBarrier& b) {
    asm volatile("s_waitcnt vmcnt(0)" ::: "memory");
    __syncthreads();
    if (threadIdx.x == 0) {
        unsigned* bar = b.bar;
        __builtin_amdgcn_s_waitcnt(0);
        unsigned nloc = b.st[0], nx = b.st[1];
        if (nloc == 0u) { xcd_barrier_complete(bar, b.x, nloc, nx); b.st[0] = nloc; b.st[1] = nx; }
        const unsigned old = xb_add(&bar[XB_XSUB(b.x)], 1u);
        const unsigned gen = old / nloc;
        if (old + 1u == (gen + 1u) * nloc) {
            __builtin_amdgcn_fence(__ATOMIC_RELEASE, "agent");
            asm volatile("s_waitcnt vmcnt(0)" ::: "memory");
            const unsigned og = xb_add(&bar[XB_TOP], 1u);
            const unsigned tg = og / nx;
            if (og + 1u == (tg + 1u) * nx) xb_add(&bar[XB_TOPGEN], 1u);
            else XB_SPIN(xb_ld(&bar[XB_TOPGEN]) == tg, bar);
            __builtin_amdgcn_fence(__ATOMIC_ACQUIRE, "agent");
            xb_add(&bar[XB_XGEN(b.x)], 1u);
            asm volatile("s_waitcnt vmcnt(0)" ::: "memory");
        } else {
            XB_SPIN(xb_ld(&bar[XB_XGEN(b.x)]) == gen, bar);
            __builtin_amdgcn_fence(__ATOMIC_ACQUIRE, "agent");
            asm volatile("s_waitcnt vmcnt(0)" ::: "memory");
        }
    }
    __syncthreads();
}


using pg8::bf16_t; using pg8::f32x4; using pg8::u32x4; using pg8::bf16x8;
using pg8::cvt_pk_bf16; using pg8::bf_lo; using pg8::bf_hi; using pg8::silu_f; using pg8::sigmoid_f; using pg8::LN_EPS_F;
typedef unsigned u32x2 __attribute__((ext_vector_type(2)));
constexpr int T_TOK = 33792, TP = 32768, NL = 4;
constexpr size_t SZ_WFI = (size_t)5632 * 1024 * 2, SZ_WFO = (size_t)1024 * 2816 * 2, SZ_WI = (size_t)2304 * 1024 * 2, SZ_WO = (size_t)1024 * 1024 * 2;
constexpr size_t WS_WFI = 0;
constexpr size_t SZ_WFI8 = (size_t)5632 * 1024;
constexpr size_t WS_P8 = WS_WFI;
static_assert(F8O_MASK_VALUE == 0xFFu, "the weight placement below needs every FFN-out matrix in e4m3 (it reuses the second half of their region)");
__host__ __device__ constexpr size_t wfi_off(int m) {
    int n8 = 0, i8 = 0, i16 = 0;
    for (int j = 0; j < 8; ++j) { const bool f = (F8_MASK_VALUE >> j) & 1u; n8 += f; if (j < m) { i8 += f; i16 += !f; } }
    const size_t base8 = WS_WFI + (size_t)33792 * 1024, base16 = base8 + (size_t)n8 * SZ_WFI8;
    const int cap = (int)((WS_WFI + 8 * SZ_WFI - base16) / SZ_WFI);
    if ((F8_MASK_VALUE >> m) & 1u) return base8 + (size_t)i8 * SZ_WFI8;
    return i16 < cap ? base16 + (size_t)i16 * SZ_WFI : WS_WFI + 8 * SZ_WFI + 4 * SZ_WFO + (size_t)(i16 - cap) * SZ_WFI;
}
constexpr bool wfi_layout_ok() { int n8 = 0; for (int j = 0; j < 8; ++j) n8 += (F8_MASK_VALUE >> j) & 1u;
    const size_t base16 = WS_WFI + (size_t)33792 * 1024 + (size_t)n8 * SZ_WFI8; const int cap = (int)((WS_WFI + 8 * SZ_WFI - base16) / SZ_WFI); return (8 - n8) - cap <= 2 && base16 <= WS_WFI + 8 * SZ_WFI; }
static_assert(wfi_layout_ok(), "FFN-in weight placement does not fit");
__host__ __device__ constexpr size_t wfo_off(int m) { return WS_WFI + 8 * SZ_WFI + (size_t)m * (SZ_WFO / 2); }
constexpr size_t WS_WFO = WS_WFI + 8 * SZ_WFI;
constexpr size_t WS_WI = WS_WFO + 8 * SZ_WFO;
constexpr size_t WS_WO = WS_WI + 4 * SZ_WI;
constexpr size_t WS_CSF = WS_WO + 4 * SZ_WO;
constexpr size_t WS_BWF = WS_CSF + 8 * 5632 * 4;
constexpr size_t WS_CSI = WS_BWF + 8 * 5632 * 4;
constexpr size_t WS_BWI = WS_CSI + 4 * 2304 * 4;
constexpr size_t WS_ONE = WS_BWI + 4 * 2304 * 4;
constexpr size_t WS_ZERO = WS_ONE + 4096;
constexpr size_t WS_ST = WS_ZERO + 4096;
constexpr size_t SZ_ST = (size_t)T_TOK * 32;
constexpr size_t WS_P = WS_ST + 13 * SZ_ST;
constexpr size_t WS_H = WS_P + (size_t)T_TOK * 1024 * 2;
constexpr size_t WS_MX = WS_H + (size_t)T_TOK * 2816 * 2;
constexpr size_t WS_BAR = WS_MX + (size_t)T_TOK * 1024 * 2;
constexpr size_t WS_PART = WS_BAR + 16384;
constexpr size_t WS_END = WS_PART + (size_t)4 * 1024 * 1024 * 4;
constexpr size_t O_SAP = 34603008, O_SCP = 34787328, O_SAS = 34795520, O_SCS = 35532800, O_SVS = 35565568;
constexpr int LDS_BYTES = 131072 + 16 + 8192;
constexpr int N_PHASES = 30;

#ifndef PROBE_REP
#define PROBE_REP 0
#endif
struct Params { const float* in[25]; float* out; unsigned char* ws; int lo, hi; };

__device__ __forceinline__ unsigned short f2bf(float f) { unsigned u = __float_as_uint(f); u += 0x7FFFu + ((u >> 16) & 1u); return (unsigned short)(u >> 16); }
__device__ __forceinline__ float bf2f(unsigned short h) { return __uint_as_float(((unsigned)h) << 16); }
__device__ __forceinline__ float wave_sum(float v, int lane) {
#pragma unroll
    for (int o = 32; o >= 1; o >>= 1) v += pg8::shx(v, o, lane);
    return v;
}

__device__ __forceinline__ void prep_weight_unit(PG8_LAS unsigned char* lds, const float* src, int ldsrc, int scol, bf16_t* dst, int K, int n0, int kbeg, int nchunks,
                                                 const float* g, const float* b, float* cs_out, float* bw_out, float f8scale = 0.f) {
    const int tid = pg8::opaque_tid(), c4 = tid & 31, kr = tid >> 5;
    PG8_LAS unsigned char* tile8 = (PG8_LAS unsigned char*)lds;
    PG8_LAS unsigned short* tile = (PG8_LAS unsigned short*)lds;
    float cs[4] = {0.f, 0.f, 0.f, 0.f}, bw[4] = {0.f, 0.f, 0.f, 0.f};
#define PREP_BAR() do { asm volatile("s_waitcnt lgkmcnt(0)" ::: "memory"); __builtin_amdgcn_s_barrier(); asm volatile("" ::: "memory"); } while (0)
    f32x4 wn[4]; float gkn[4], bkn[4];
#pragma unroll
    for (int i = 0; i < 4; ++i) { const int k = kbeg + kr + 16 * i; wn[i] = *(const f32x4*)(src + (size_t)k * ldsrc + scol + 4 * c4); gkn[i] = g ? g[k] : 1.0f; bkn[i] = b ? b[k] : 0.0f; }
    for (int ch = 0; ch < nchunks; ++ch) {
        const int k0 = kbeg + ch * 64;
        f32x4 w[4]; float gk[4], bk[4];
#pragma unroll
        for (int i = 0; i < 4; ++i) { w[i] = wn[i]; gk[i] = gkn[i]; bk[i] = bkn[i]; }
        if (ch + 1 < nchunks) {
#pragma unroll
            for (int i = 0; i < 4; ++i) { const int k = k0 + 64 + kr + 16 * i; wn[i] = *(const f32x4*)(src + (size_t)k * ldsrc + scol + 4 * c4); gkn[i] = g ? g[k] : 1.0f; bkn[i] = b ? b[k] : 0.0f; }
        }
        PREP_BAR();
        if (f8scale != 0.f) {
            const float inv = 1.0f / f8scale;
#pragma unroll
            for (int i = 0; i < 4; ++i) {
                const f32x4 v = w[i] * (gk[i] * f8scale); const unsigned pk = pg8::f8x4(v[0], v[1], v[2], v[3]);
#pragma unroll
                for (int e = 0; e < 4; ++e) { tile8[(4 * c4 + e) * 68 + kr + 16 * i] = (unsigned char)(pk >> (8 * e)); bw[e] += w[i][e] * bk[i]; }
                cs[0] += __builtin_amdgcn_cvt_f32_fp8((int)pk, 0) * inv; cs[1] += __builtin_amdgcn_cvt_f32_fp8((int)pk, 1) * inv; cs[2] += __builtin_amdgcn_cvt_f32_fp8((int)pk, 2) * inv; cs[3] += __builtin_amdgcn_cvt_f32_fp8((int)pk, 3) * inv;
            }
            PREP_BAR();
            const int n = tid >> 2, q = tid & 3;
            const PG8_LAS unsigned* rowp = (const PG8_LAS unsigned*)(tile8 + n * 68 + 16 * q);
            u32x4 o0; o0.x = rowp[0]; o0.y = rowp[1]; o0.z = rowp[2]; o0.w = rowp[3];
            *(u32x4*)((unsigned char*)dst + (size_t)(n0 + n) * K + k0 + 16 * q) = o0;
        } else {
#pragma unroll
        for (int i = 0; i < 4; ++i)
#pragma unroll
            for (int e = 0; e < 4; ++e) { const unsigned short hb = f2bf(w[i][e] * gk[i]); tile[(4 * c4 + e) * 66 + kr + 16 * i] = hb; cs[e] += bf2f(hb); bw[e] += w[i][e] * bk[i]; }
        PREP_BAR();
        const int n = tid >> 2, q = tid & 3;
        const PG8_LAS unsigned* rowp = (const PG8_LAS unsigned*)(tile + n * 66 + 16 * q);
        u32x4 o0, o1; o0.x = rowp[0]; o0.y = rowp[1]; o0.z = rowp[2]; o0.w = rowp[3]; o1.x = rowp[4]; o1.y = rowp[5]; o1.z = rowp[6]; o1.w = rowp[7];
        bf16_t* d = dst + (size_t)(n0 + n) * K + k0 + 16 * q;
        *(u32x4*)d = o0; *(u32x4*)(d + 8) = o1;
        }
    }
    if (cs_out) {
        __syncthreads();
        PG8_LAS float* red = (PG8_LAS float*)(lds + 32768);
#pragma unroll
        for (int e = 0; e < 4; ++e) { red[(kr * 128 + 4 * c4 + e) * 2] = cs[e]; red[(kr * 128 + 4 * c4 + e) * 2 + 1] = bw[e]; }
        __syncthreads();
        if (tid < 128) { float a = 0.f, q = 0.f;
#pragma unroll
            for (int r = 0; r < 16; ++r) { a += red[(r * 128 + tid) * 2]; q += red[(r * 128 + tid) * 2 + 1]; }
            cs_out[n0 + tid] = a; bw_out[n0 + tid] = q; }
    }
    __syncthreads();
}

__device__ __forceinline__ void prep_phase(PG8_LAS unsigned char* lds, const Params& p) {
    unsigned char* ws = p.ws; const int G = gridDim.x;
    for (int it = 0; it < 16; ++it) {
        int idx;
        if (G == 256) {
            const int b = (int)blockIdx.x;
            if (it < 2) { idx = b + 256 * it; if (idx >= 424) continue; }
            else if (b >= 168) { if (it >= 8) break; idx = 424 + 6 * (b - 168) + (it - 2); }
            else { if (it >= 4) break; const int j = 528 + b + 168 * (it - 2); if (j >= 832) continue; idx = 424 + j; }
        } else { idx = (int)blockIdx.x + it * G; if (idx >= 1256) break; }
        if (idx < 352) {
            const int m = idx / 44, strip = idx % 44, l = m >> 1, f = m & 1, pn = strip >> 1, bj = strip & 1;
            const float* src = p.in[f ? 21 : 4] + (size_t)l * 1024 * 5632;
            const float* g = f ? p.in[19] + l * 1024 : (l ? p.in[23] + (l - 1) * 1024 : nullptr);
            const float* b = f ? p.in[20] + l * 1024 : (l ? p.in[24] + (l - 1) * 1024 : nullptr);
            prep_weight_unit(lds, src, 5632, bj * 2816 + 128 * pn, (bf16_t*)(ws + wfi_off(m)), 1024, strip * 128, 0, 16, g, b,
                             (float*)(ws + WS_CSF) + m * 5632, (float*)(ws + WS_BWF) + m * 5632, pg8::is_f8(m) ? pg8::F8_WSCALE : 0.f);
        } else if (idx < 424) {
            const int j = idx - 352, l = j / 18, strip = j % 18;
            prep_weight_unit(lds, p.in[8] + (size_t)l * 1024 * 2304, 2304, strip * 128, (bf16_t*)(ws + WS_WI + l * SZ_WI), 1024, strip * 128, 0, 16, p.in[6] + l * 1024, p.in[7] + l * 1024,
                             (float*)(ws + WS_CSI) + l * 2304, (float*)(ws + WS_BWI) + l * 2304);
        } else if (idx < 1128) {
            const int j = idx - 424, m = j / 88, rem = j % 88, strip = rem / 11, kq = rem % 11, l = m >> 1, f = m & 1;
            prep_weight_unit(lds, p.in[f ? 22 : 5] + (size_t)l * 2816 * 1024, 1024, strip * 128, (bf16_t*)(ws + wfo_off(m)), 2816, strip * 128, kq * 256, 4, nullptr, nullptr, nullptr, nullptr, pg8::is_f8o(m) ? pg8::F8_WOSCALE : 0.f);
        } else {
            const int j = idx - 1128, l = j / 32, rem = j % 32, strip = rem / 4, kq = rem % 4;
            prep_weight_unit(lds, p.in[18] + (size_t)l * 1024 * 1024, 1024, strip * 128, (bf16_t*)(ws + WS_WO + l * SZ_WO), 1024, strip * 128, kq * 256, 4, nullptr, nullptr, nullptr, nullptr);
        }
    }
    const size_t gt = (size_t)blockIdx.x * 512 + pg8::opaque_tid(), gn = (size_t)G * 512;
    bf16_t* P = (bf16_t*)(ws + WS_P);
    for (size_t i = gt; i < (size_t)T_TOK * 1024 / 8; i += gn) {
        const size_t e = i * 8; const float* s = e < (size_t)TP * 1024 ? p.in[0] + e : p.in[1] + (e - (size_t)TP * 1024);
        const f32x4 a = *(const f32x4*)s, c = *(const f32x4*)(s + 4);
        u32x4 w; w.x = cvt_pk_bf16(a[0], a[1]); w.y = cvt_pk_bf16(a[2], a[3]); w.z = cvt_pk_bf16(c[0], c[1]); w.w = cvt_pk_bf16(c[2], c[3]);
        *(u32x4*)(P + e) = w;
        if (pg8::is_f8(0)) *(pg8::u32x2v*)(ws + WS_P8 + e) = (pg8::u32x2v){pg8::f8x4(a[0], a[1], a[2], a[3]), pg8::f8x4(c[0], c[1], c[2], c[3])};
    }
    float* st = (float*)(ws + WS_ST);
    { float one = 1.0f; asm volatile("" : "+v"(one));
      const float idv = one * (1024.0f * (1.0f - 1e-5f)), zz = one * 0.0f;
      for (size_t i = gt; i < (size_t)T_TOK; i += gn) { *(f32x4*)(st + 8 * i) = (f32x4){zz, idv, zz, zz}; *(f32x4*)(st + 8 * i + 4) = (f32x4){zz, zz, zz, zz}; } }
    if (gt < 1024) { ((float*)(ws + WS_ONE))[gt] = 1.0f; ((float*)(ws + WS_ZERO))[gt] = 0.0f; }
}

__device__ __forceinline__ void mixer_a_unit(PG8_LAS unsigned char* lds, int u, int l, const bf16_t* Z, bf16_t* MX, const Params& p) {
    const int tid = pg8::opaque_tid(), tb = u * 32;
    const bool samp = tb >= TP;
    int b, t0, T, seqbase;
    if (!samp) { b = tb >> 13; t0 = tb & 8191; T = 8192; seqbase = b << 13; } else { const int rs = tb - TP; b = rs >> 6; t0 = rs & 63; T = 64; seqbase = TP + (b << 6); }
    PG8_LAS unsigned short* ae = (PG8_LAS unsigned short*)lds;
    PG8_LAS float* cv = (PG8_LAS float*)(lds + 49152);
    __syncthreads();
    {
        const bool wr_state = (t0 + 32 == T);
        float* so = samp ? p.out + O_SAS + (size_t)(l * 16 + b) * 30 * 384 : p.out + O_SAP + (size_t)(l * 4 + b) * 30 * 384;
        const float* hist = p.in[2] + (size_t)(l * 16 + b) * 30 * 384;
        if (t0 != 0) {
            u32x4 pwv[6], gwv[6];
#pragma unroll
            for (int q = 0; q < 6; ++q) { int it = tid + 512 * q; it = it < 62 * 48 ? it : 0; const int i = it / 48, c = (it - i * 48) * 8;
                const char* zr = (const char*)Z + ((unsigned)(seqbase + t0 - 30 + i) * 4608u + (unsigned)c * 2u); pwv[q] = *(const u32x4*)zr; gwv[q] = *(const u32x4*)(zr + 768); }
#pragma unroll
            for (int q = 0; q < 6; ++q) { const int it = tid + 512 * q; if (it < 62 * 48) { const int i = it / 48, c = (it - i * 48) * 8; const u32x4 pw = pwv[q], gw = gwv[q]; float a[8];
                a[0] = bf_lo(pw.x) * sigmoid_f(bf_lo(gw.x)); a[1] = bf_hi(pw.x) * sigmoid_f(bf_hi(gw.x)); a[2] = bf_lo(pw.y) * sigmoid_f(bf_lo(gw.y)); a[3] = bf_hi(pw.y) * sigmoid_f(bf_hi(gw.y));
                a[4] = bf_lo(pw.z) * sigmoid_f(bf_lo(gw.z)); a[5] = bf_hi(pw.z) * sigmoid_f(bf_hi(gw.z)); a[6] = bf_lo(pw.w) * sigmoid_f(bf_lo(gw.w)); a[7] = bf_hi(pw.w) * sigmoid_f(bf_hi(gw.w));
                u32x4 w; w.x = cvt_pk_bf16(a[0], a[1]); w.y = cvt_pk_bf16(a[2], a[3]); w.z = cvt_pk_bf16(a[4], a[5]); w.w = cvt_pk_bf16(a[6], a[7]);
                *(PG8_LAS u32x4*)(ae + i * 384 + c) = w;
                if (wr_state && i >= 32) { float* d = so + (i - 32) * 384 + c; *(f32x4*)d = (f32x4){a[0], a[1], a[2], a[3]}; *(f32x4*)(d + 4) = (f32x4){a[4], a[5], a[6], a[7]}; } } }
        } else
        for (int it = tid; it < 62 * 48; it += 512) {
            const int i = it / 48, c = (it - i * 48) * 8, t = t0 - 30 + i;
            float a[8];
            if (t >= 0) {
                const char* zr = (const char*)Z + ((unsigned)(seqbase + t) * 4608u + (unsigned)c * 2u);
                const u32x4 pw = *(const u32x4*)zr, gw = *(const u32x4*)(zr + 768);
                a[0] = bf_lo(pw.x) * sigmoid_f(bf_lo(gw.x)); a[1] = bf_hi(pw.x) * sigmoid_f(bf_hi(gw.x)); a[2] = bf_lo(pw.y) * sigmoid_f(bf_lo(gw.y)); a[3] = bf_hi(pw.y) * sigmoid_f(bf_hi(gw.y));
                a[4] = bf_lo(pw.z) * sigmoid_f(bf_lo(gw.z)); a[5] = bf_hi(pw.z) * sigmoid_f(bf_hi(gw.z)); a[6] = bf_lo(pw.w) * sigmoid_f(bf_lo(gw.w)); a[7] = bf_hi(pw.w) * sigmoid_f(bf_hi(gw.w));
            } else if (samp) {
                const f32x4 h0 = *(const f32x4*)(hist + (30 + t) * 384 + c), h1 = *(const f32x4*)(hist + (30 + t) * 384 + c + 4);
#pragma unroll
                for (int e = 0; e < 4; ++e) { a[e] = h0[e]; a[4 + e] = h1[e]; }
            } else {
#pragma unroll
                for (int e = 0; e < 8; ++e) a[e] = 0.f;
            }
            u32x4 w; w.x = cvt_pk_bf16(a[0], a[1]); w.y = cvt_pk_bf16(a[2], a[3]); w.z = cvt_pk_bf16(a[4], a[5]); w.w = cvt_pk_bf16(a[6], a[7]);
            *(PG8_LAS u32x4*)(ae + i * 384 + c) = w;
            if (wr_state && i >= 32) { float* d = so + (i - 32) * 384 + c; *(f32x4*)d = (f32x4){a[0], a[1], a[2], a[3]}; *(f32x4*)(d + 4) = (f32x4){a[4], a[5], a[6], a[7]}; }
        }
    }
    __syncthreads();
    if (tid < 384) {
        const int th = tid >= 192 ? 1 : 0, c = 2 * (tid - 192 * th);
        pg8::f32x2 av[46];
#pragma unroll
        for (int i = 0; i < 46; ++i) { const unsigned w = *(const PG8_LAS unsigned*)(ae + (16 * th + i) * 384 + c); av[i] = (pg8::f32x2){bf_lo(w), bf_hi(w)}; }
        pg8::f32x2 wv[31];
        const float* cw = p.in[9] + (size_t)l * 31 * 384 + c;
#pragma unroll
        for (int k = 0; k < 31; ++k) wv[k] = *(const pg8::f32x2*)(cw + k * 384);
        const pg8::f32x2 bias = *(const pg8::f32x2*)(p.in[10] + l * 384 + c);
#pragma unroll
        for (int j = 0; j < 16; ++j) { pg8::f32x2 acc = bias;
#pragma unroll
            for (int k = 0; k < 31; ++k) acc += wv[k] * av[j + k];
            *(PG8_LAS pg8::f32x2*)(cv + (16 * th + j) * 384 + c) = acc; }
    }
    __syncthreads();
    const int wave = tid >> 6, lane = tid & 63;
    const float* ng = p.in[11] + l * 384; const float* nb = p.in[12] + l * 384;
    pg8::f32x2 gg[3], bb[3];
#pragma unroll
    for (int i = 0; i < 3; ++i) { gg[i] = *(const pg8::f32x2*)(ng + 2 * (lane + 64 * i)); bb[i] = *(const pg8::f32x2*)(nb + 2 * (lane + 64 * i)); }
    pg8::f32x2 x[4][3]; float sm[4], sq[4];
#pragma unroll
    for (int tt = 0; tt < 4; ++tt) { sm[tt] = 0.f;
#pragma unroll
        for (int i = 0; i < 3; ++i) { x[tt][i] = *(const PG8_LAS pg8::f32x2*)(cv + (wave * 4 + tt) * 384 + 2 * (lane + 64 * i)); sm[tt] += x[tt][i][0] + x[tt][i][1]; } }
#pragma unroll
    for (int o = 32; o >= 1; o >>= 1)
#pragma unroll
        for (int tt = 0; tt < 4; ++tt) sm[tt] += pg8::shx(sm[tt], o, lane);
#pragma unroll
    for (int tt = 0; tt < 4; ++tt) { const float mean = sm[tt] * (1.0f / 384.0f); sq[tt] = 0.f;
#pragma unroll
        for (int i = 0; i < 3; ++i) { x[tt][i] -= mean; sq[tt] += x[tt][i][0] * x[tt][i][0] + x[tt][i][1] * x[tt][i][1]; } }
#pragma unroll
    for (int o = 32; o >= 1; o >>= 1)
#pragma unroll
        for (int tt = 0; tt < 4; ++tt) sq[tt] += pg8::shx(sq[tt], o, lane);
#pragma unroll
    for (int tt = 0; tt < 4; ++tt) {
        const unsigned row = (unsigned)(seqbase + t0 + wave * 4 + tt);
        const float rstd = rsqrtf(sq[tt] * (1.0f / 384.0f) + LN_EPS_F);
#pragma unroll
        for (int i = 0; i < 3; ++i) { const float y0 = x[tt][i][0] * rstd * gg[i][0] + bb[i][0], y1 = x[tt][i][1] * rstd * gg[i][1] + bb[i][1];
            *(unsigned*)((char*)MX + (row * 2048u + 4u * (unsigned)(lane + 64 * i))) = cvt_pk_bf16(silu_f(y0), silu_f(y1)); }
    }
}
__device__ __forceinline__ void mixer_b_unit(PG8_LAS unsigned char* lds, int blk, int l, const bf16_t* Z, bf16_t* MX, const Params& p) {
    const int tid = pg8::opaque_tid(), wave = tid >> 6, lane = tid & 63, fr = lane & 15, fq = lane >> 4;
    const int row0 = blk * 128; const bool samp = row0 >= TP;
    const float* ng = p.in[13] + l * 384; const float* nb = p.in[14] + l * 384;
    PG8_LAS unsigned short* vT = (PG8_LAS unsigned short*)lds;
    __syncthreads();
    float gg[6], bb[6];
#pragma unroll
    for (int i = 0; i < 3; ++i) { const int c = 2 * lane + 128 * i; gg[2 * i] = ng[c]; gg[2 * i + 1] = ng[c + 1]; bb[2 * i] = nb[c]; bb[2 * i + 1] = nb[c + 1]; }
    for (int g8 = 0; g8 < 2; ++g8) {
        unsigned pk[6][4];
        unsigned zw[8][3];
#pragma unroll
        for (int jj = 0; jj < 8; ++jj)
#pragma unroll
            for (int i = 0; i < 3; ++i) zw[jj][i] = *(const unsigned*)((const char*)Z + ((unsigned)(row0 + wave * 16 + g8 * 8 + jj) * 4608u + 2304u + 4u * (unsigned)lane + 256u * i));
        float v[8][6], sm[8], sq[8];
#pragma unroll
        for (int jj = 0; jj < 8; ++jj) { sm[jj] = 0.f;
#pragma unroll
            for (int i = 0; i < 3; ++i) { const unsigned w = zw[jj][i]; v[jj][2 * i] = bf_lo(w); v[jj][2 * i + 1] = bf_hi(w); sm[jj] += v[jj][2 * i] + v[jj][2 * i + 1]; } }
#pragma unroll
        for (int o = 32; o >= 1; o >>= 1)
#pragma unroll
            for (int jj = 0; jj < 8; ++jj) sm[jj] += pg8::shx(sm[jj], o, lane);
#pragma unroll
        for (int jj = 0; jj < 8; ++jj) { const float mean = sm[jj] * (1.0f / 384.0f); sq[jj] = 0.f;
#pragma unroll
            for (int i = 0; i < 6; ++i) { v[jj][i] -= mean; sq[jj] += v[jj][i] * v[jj][i]; } }
#pragma unroll
        for (int o = 32; o >= 1; o >>= 1)
#pragma unroll
            for (int jj = 0; jj < 8; ++jj) sq[jj] += pg8::shx(sq[jj], o, lane);
#pragma unroll
        for (int jj = 0; jj < 8; ++jj) {
            const unsigned row = (unsigned)(row0 + wave * 16 + g8 * 8 + jj);
            const float rstd = rsqrtf(sq[jj] * (1.0f / 384.0f) + LN_EPS_F);
#pragma unroll
            for (int i = 0; i < 6; ++i) v[jj][i] = v[jj][i] * rstd * gg[i] + bb[i];
            if (samp) {
#pragma unroll
                for (int i = 0; i < 3; ++i) *(pg8::f32x2*)(p.out + O_SVS + ((size_t)l * 1024 + (row - TP)) * 384 + 2 * lane + 128 * i) = (pg8::f32x2){v[jj][2 * i], v[jj][2 * i + 1]};
            }
#pragma unroll
            for (int i = 0; i < 6; ++i) { const unsigned hb = f2bf(v[jj][i]); if (jj & 1) pk[i][jj >> 1] |= hb << 16; else pk[i][jj >> 1] = hb; }
        }
#pragma unroll
        for (int i = 0; i < 6; ++i) { const int c = 2 * lane + 128 * (i >> 1) + (i & 1); u32x4 w; w.x = pk[i][0]; w.y = pk[i][1]; w.z = pk[i][2]; w.w = pk[i][3];
            *(PG8_LAS u32x4*)(vT + c * 136 + wave * 16 + g8 * 8) = w; }
    }
    __syncthreads();
    const int i_loc = wave * 16 + fr;
    const size_t orow = (size_t)(row0 + i_loc);
#pragma unroll 2
    for (int h = 0; h < 6; ++h) {
        f32x4 acc[4];
#pragma unroll
        for (int dt = 0; dt < 4; ++dt) acc[dt] = (f32x4){0.f, 0.f, 0.f, 0.f};
        const float* wh = p.in[15] + (size_t)(l * 6 + h) * 128 * 128;
        f32x4 wq[4][2]; u32x2 uw[4];
#pragma unroll
        for (int ks = 0; ks < 4; ++ks) {
            const int j0 = ks * 32 + fq * 8;
            bool valid; const float* src;
            if (!samp) { valid = (j0 >> 6) <= (i_loc >> 6); src = wh + i_loc * 128 + j0; }
            else { valid = (j0 >> 6) == (i_loc >> 6); src = wh + (i_loc & 63) * 128 + (j0 & 63); }
            wq[ks][0] = *(const f32x4*)src; wq[ks][1] = *(const f32x4*)(src + 4);
            if (!valid) { wq[ks][0] = (f32x4){0.f, 0.f, 0.f, 0.f}; wq[ks][1] = wq[ks][0]; }
        }
#pragma unroll
        for (int dt = 0; dt < 4; ++dt) uw[dt] = *(const u32x2*)((const char*)Z + ((unsigned)orow * 4608u + 1536u + 2u * (unsigned)(h * 64 + dt * 16 + fq * 4)));
#pragma unroll
        for (int ks = 0; ks < 4; ++ks) {
            const int j0 = ks * 32 + fq * 8;
            union { bf16x8 v; unsigned u[4]; } wf;
            wf.u[0] = cvt_pk_bf16(wq[ks][0][0], wq[ks][0][1]); wf.u[1] = cvt_pk_bf16(wq[ks][0][2], wq[ks][0][3]); wf.u[2] = cvt_pk_bf16(wq[ks][1][0], wq[ks][1][1]); wf.u[3] = cvt_pk_bf16(wq[ks][1][2], wq[ks][1][3]);
#pragma unroll
            for (int dt = 0; dt < 4; ++dt) {
                const bf16x8 vf = *(const PG8_LAS bf16x8*)(vT + (h * 64 + dt * 16 + fr) * 136 + j0);
                acc[dt] = __builtin_amdgcn_mfma_f32_16x16x32_bf16(vf, wf.v, acc[dt], 0, 0, 0);
            }
        }
        const float bias = p.in[16][(l * 6 + h) * 128 + (samp ? (i_loc & 63) : i_loc)];
#pragma unroll
        for (int dt = 0; dt < 4; ++dt) {
            const int d = h * 64 + dt * 16 + fq * 4;
            const float o0 = bf_lo(uw[dt].x) * (acc[dt][0] + bias), o1 = bf_hi(uw[dt].x) * (acc[dt][1] + bias), o2 = bf_lo(uw[dt].y) * (acc[dt][2] + bias), o3 = bf_hi(uw[dt].y) * (acc[dt][3] + bias);
            u32x2 ow; ow.x = cvt_pk_bf16(o0, o1); ow.y = cvt_pk_bf16(o2, o3);
            *(u32x2*)(MX + orow * 1024 + 384 + d) = ow;
        }
    }
}
__device__ __forceinline__ void mixer_c_items(int l, const bf16_t* Z, bf16_t* MX, const Params& p) {
    const unsigned gt = blockIdx.x * 512u + (unsigned)pg8::opaque_tid(), gn = gridDim.x * 512u;
    const char* Zb = (const char*)Z;
    for (unsigned it = gt; it < (unsigned)T_TOK * 32u; it += gn) {
        const int row = (int)(it >> 5), c = (int)(it & 31) * 8;
        const bool samp = row >= TP;
        int b, t, T; if (!samp) { b = row >> 13; t = row & 8191; T = 8192; } else { const int rs = row - TP; b = rs >> 6; t = rs & 63; T = 64; }
        float cx[3][8];
        if (t >= 2) {
            u32x4 xw[3], gw[3];
#pragma unroll
            for (int k = 0; k < 3; ++k) { const unsigned ro = (unsigned)(row - 2 + k) * 4608u + (unsigned)c * 2u; xw[k] = *(const u32x4*)(Zb + ro + 3072u); gw[k] = *(const u32x4*)(Zb + ro + 4096u); }
#pragma unroll
            for (int k = 0; k < 3; ++k) {
                cx[k][0] = bf_lo(xw[k].x) * bf_lo(gw[k].x); cx[k][1] = bf_hi(xw[k].x) * bf_hi(gw[k].x); cx[k][2] = bf_lo(xw[k].y) * bf_lo(gw[k].y); cx[k][3] = bf_hi(xw[k].y) * bf_hi(gw[k].y);
                cx[k][4] = bf_lo(xw[k].z) * bf_lo(gw[k].z); cx[k][5] = bf_hi(xw[k].z) * bf_hi(gw[k].z); cx[k][6] = bf_lo(xw[k].w) * bf_lo(gw[k].w); cx[k][7] = bf_hi(xw[k].w) * bf_hi(gw[k].w);
            }
        } else
#pragma unroll
        for (int k = 0; k < 3; ++k) {
            const int tt = t - 2 + k;
            if (tt >= 0) {
                const unsigned ro = (unsigned)(row - 2 + k) * 4608u + (unsigned)c * 2u;
                const u32x4 xw = *(const u32x4*)(Zb + ro + 3072u), gw = *(const u32x4*)(Zb + ro + 4096u);
                cx[k][0] = bf_lo(xw.x) * bf_lo(gw.x); cx[k][1] = bf_hi(xw.x) * bf_hi(gw.x); cx[k][2] = bf_lo(xw.y) * bf_lo(gw.y); cx[k][3] = bf_hi(xw.y) * bf_hi(gw.y);
                cx[k][4] = bf_lo(xw.z) * bf_lo(gw.z); cx[k][5] = bf_hi(xw.z) * bf_hi(gw.z); cx[k][6] = bf_lo(xw.w) * bf_lo(gw.w); cx[k][7] = bf_hi(xw.w) * bf_hi(gw.w);
            } else if (samp) {
                const float* hc = p.in[3] + ((size_t)(l * 16 + b) * 2 + (2 + tt)) * 256 + c;
                const f32x4 h0 = *(const f32x4*)hc, h1 = *(const f32x4*)(hc + 4);
#pragma unroll
                for (int e = 0; e < 4; ++e) { cx[k][e] = h0[e]; cx[k][4 + e] = h1[e]; }
            } else {
#pragma unroll
                for (int e = 0; e < 8; ++e) cx[k][e] = 0.f;
            }
        }
        const u32x4 gb = *(const u32x4*)(Zb + ((unsigned)row * 4608u + 3584u + (unsigned)c * 2u));
        float gbf[8]; gbf[0] = bf_lo(gb.x); gbf[1] = bf_hi(gb.x); gbf[2] = bf_lo(gb.y); gbf[3] = bf_hi(gb.y); gbf[4] = bf_lo(gb.z); gbf[5] = bf_hi(gb.z); gbf[6] = bf_lo(gb.w); gbf[7] = bf_hi(gb.w);
        float o[8];
#pragma unroll
        for (int e = 0; e < 8; ++e) o[e] = 0.f;
#pragma unroll
        for (int k = 0; k < 3; ++k) {
            const float* wk = p.in[17] + (size_t)(l * 3 + k) * 256 + c;
            const f32x4 w0 = *(const f32x4*)wk, w1 = *(const f32x4*)(wk + 4);
#pragma unroll
            for (int e = 0; e < 4; ++e) { o[e] += w0[e] * cx[k][e]; o[4 + e] += w1[e] * cx[k][4 + e]; }
        }
        u32x4 ow; ow.x = cvt_pk_bf16(gbf[0] * o[0], gbf[1] * o[1]); ow.y = cvt_pk_bf16(gbf[2] * o[2], gbf[3] * o[3]); ow.z = cvt_pk_bf16(gbf[4] * o[4], gbf[5] * o[5]); ow.w = cvt_pk_bf16(gbf[6] * o[6], gbf[7] * o[7]);
        *(u32x4*)((char*)MX + ((unsigned)row * 2048u + 1536u + (unsigned)c * 2u)) = ow;
        if (t >= T - 2) {
            float* so = (samp ? p.out + O_SCS + ((size_t)(l * 16 + b) * 2 + (t - (T - 2))) * 256 : p.out + O_SCP + ((size_t)(l * 4 + b) * 2 + (t - (T - 2))) * 256) + c;
            *(f32x4*)so = (f32x4){cx[2][0], cx[2][1], cx[2][2], cx[2][3]}; *(f32x4*)(so + 4) = (f32x4){cx[2][4], cx[2][5], cx[2][6], cx[2][7]};
        }
    }
}
__device__ __forceinline__ void mixer_phase(PG8_LAS unsigned char* lds, int l, const Params& p) {
    const bf16_t* Z = (const bf16_t*)(p.ws + WS_H); bf16_t* MX = (bf16_t*)(p.ws + WS_MX); const int G = gridDim.x;
    for (int ub = blockIdx.x; ub < 264; ub += G) mixer_b_unit(lds, ub, l, Z, MX, p);
    for (int ua = G - 1 - blockIdx.x; ua < 1056; ua += G) mixer_a_unit(lds, ua, l, Z, MX, p);
    mixer_c_items(l, Z, MX, p);
    __syncthreads();
}
__device__ __forceinline__ void sample_reduce(const Params& p, unsigned char* ws, const float* st_old, const float* g, const float* b, float* st_new, float scale, unsigned char* p8) {
    const int tid = pg8::opaque_tid(), wave = tid >> 6, lane = tid & 63;
    const bf16_t* part = (const bf16_t*)(ws + WS_PART); bf16_t* P = (bf16_t*)(ws + WS_P);
    for (int it = blockIdx.x * 8 + wave; it < 4096; it += gridDim.x * 8) {
        const int rl = it >> 2, pn = it & 3, r = TP + rl, c = pn * 256 + 4 * lane;
        const size_t po = (size_t)rl * 1024 + c;
        f32x4 q0, q1, q2, q3;
        { const u32x2 w0 = *(const u32x2*)(part + po), w1 = *(const u32x2*)(part + po + 1048576), w2 = *(const u32x2*)(part + po + 2 * 1048576), w3 = *(const u32x2*)(part + po + 3 * 1048576);
          q0 = (f32x4){bf_lo(w0.x), bf_hi(w0.x), bf_lo(w0.y), bf_hi(w0.y)}; q1 = (f32x4){bf_lo(w1.x), bf_hi(w1.x), bf_lo(w1.y), bf_hi(w1.y)};
          q2 = (f32x4){bf_lo(w2.x), bf_hi(w2.x), bf_lo(w2.y), bf_hi(w2.y)}; q3 = (f32x4){bf_lo(w3.x), bf_hi(w3.x), bf_lo(w3.y), bf_hi(w3.y)}; }
        const f32x4 acc = ((q0 + q1) + q2) + q3;
        float mu, rs; pg8::row_stats(st_old, r, mu, rs); rs *= pg8::ALPHA_F;
        const u32x2 pw = *(const u32x2*)(P + (size_t)r * 1024 + c);
        f32x4 x; x[0] = bf_lo(pw.x); x[1] = bf_hi(pw.x); x[2] = bf_lo(pw.y); x[3] = bf_hi(pw.y);
        const f32x4 gv = *(const f32x4*)(g + c), bv = *(const f32x4*)(b + c);
        f32x4 v = ((x - mu) * rs) * gv + (bv * pg8::ALPHA_F + scale * acc);
        { u32x2 w; w.x = cvt_pk_bf16(v[0], v[1]); w.y = cvt_pk_bf16(v[2], v[3]); *(u32x2*)(P + (size_t)r * 1024 + c) = w;
            if (p8) *(unsigned*)(p8 + (size_t)r * 1024 + c) = pg8::f8x4(v[0], v[1], v[2], v[3]);
            v[0] = bf_lo(w.x); v[1] = bf_hi(w.x); v[2] = bf_lo(w.y); v[3] = bf_hi(w.y); }
        const float sm = wave_sum((v[0] + v[1]) + (v[2] + v[3]), lane), sq = wave_sum((v[0] * v[0] + v[1] * v[1]) + (v[2] * v[2] + v[3] * v[3]), lane);
        if (lane == 0) *(pg8::f32x2*)(st_new + 8 * (size_t)r + 2 * pn) = (pg8::f32x2){sm, sq};
    }
}
__device__ __forceinline__ void final_phase(const Params& p) {
    const float* st = (const float*)(p.ws + WS_ST + 12 * SZ_ST); const float* g = p.in[23] + 3 * 1024; const float* b = p.in[24] + 3 * 1024;
    const size_t gt = (size_t)blockIdx.x * 512 + pg8::opaque_tid(), gn = (size_t)gridDim.x * 512;
    const bf16_t* P = (const bf16_t*)(p.ws + WS_P);
    for (size_t i = gt; i < (size_t)T_TOK * 128; i += gn) {
        const int r = (int)(i >> 7), c = (int)(i & 127) * 8; float mu, rstd; pg8::row_stats(st, r, mu, rstd);
        const u32x4 w = *(const u32x4*)(P + (size_t)r * 1024 + c);
        f32x4 v0, v1; v0[0] = bf_lo(w.x); v0[1] = bf_hi(w.x); v0[2] = bf_lo(w.y); v0[3] = bf_hi(w.y); v1[0] = bf_lo(w.z); v1[1] = bf_hi(w.z); v1[2] = bf_lo(w.w); v1[3] = bf_hi(w.w);
        const f32x4 g0 = *(const f32x4*)(g + c), g1 = *(const f32x4*)(g + c + 4), b0 = *(const f32x4*)(b + c), b1 = *(const f32x4*)(b + c + 4);
        *(f32x4*)(p.out + (size_t)r * 1024 + c) = (v0 - mu) * rstd * g0 + b0; *(f32x4*)(p.out + (size_t)r * 1024 + c + 4) = (v1 - mu) * rstd * g1 + b1;
    }
}

__global__ void __launch_bounds__(512, 2) fwd_kernel(Params p) {
    extern __shared__ __attribute__((aligned(16))) unsigned char shm[];
    PG8_LAS unsigned char* lds = (PG8_LAS unsigned char*)shm;
    unsigned char* ws0 = p.ws; const int G = gridDim.x;
    unsigned char* ws = ws0;
    if (threadIdx.x < 4) ((PG8_LAS unsigned*)(lds + 131072))[threadIdx.x] = 0u;
    __syncthreads();
    XcdBarrier xbar = xcd_barrier_post((unsigned*)(ws + WS_BAR), (volatile LAS unsigned*)(lds + 131072));
    for (int ph = p.lo; ph < p.hi; ++ph) {
        { unsigned long long wsi = (unsigned long long)ws0; asm volatile("" : "+s"(wsi));
          ws = (unsigned char*)(__attribute__((address_space(1))) unsigned char*)wsi; }
        bf16_t* P = (bf16_t*)(ws + WS_P); bf16_t* H = (bf16_t*)(ws + WS_H); bf16_t* MX = (bf16_t*)(ws + WS_MX);
        float* ST = (float*)(ws + WS_ST);
        const bf16_t* sp_A = nullptr; const bf16_t* sp_B = nullptr; const float* sp_go = nullptr; const float* sp_bo = nullptr; const float* sp_stold = nullptr; float* sp_stnew = nullptr; unsigned char* sp_p8 = nullptr; float sp_scale = 0.f; int sp_K = 0; bool do_split = false;
#ifndef NO_PREP
        if (ph == 0) { prep_phase(lds, p); } else
#endif
        if (ph == N_PHASES - 1) final_phase(p);
        else {
            const int l = (ph - 1) / 7, s = (ph - 1) % 7;
            if (s == 0 || s == 5) {
                const int f = s == 5, m = l * 2 + f;
                pg8::StaticOrder S; S.init(T_TOK, 5632, G, (int)blockIdx.x);
                pg8::EpiSwiGLU E{H, ST + (size_t)(f ? 2 + 3 * l : 3 * l) * T_TOK * 8, (const float*)(ws + WS_CSF) + m * 5632, (const float*)(ws + WS_BWF) + m * 5632, pg8::is_f8(m) ? 1.0f / pg8::F8_WSCALE : 1.0f, pg8::is_f8o(m) ? pg8::F8_HSCALE : 0.f, lds + 131072 + 16};
#ifndef NO_SWI
                if (pg8::is_f8(m)) { pg8::Gemm g{(const bf16_t*)(ws + WS_P8), (const bf16_t*)(ws + wfi_off(m)), T_TOK, 5632, 512, 512};
                    pg8::gemm_phase<pg8::EpiSwiGLU, pg8::StaticOrder, false, true>(lds, g, S, E, nullptr); }
                else { pg8::Gemm g{P, (const bf16_t*)(ws + wfi_off(m)), T_TOK, 5632, 1024, 1024};
                    pg8::gemm_phase<pg8::EpiSwiGLU, pg8::StaticOrder, false, false>(lds, g, S, E, nullptr); }
#endif
            } else if (s == 1 || s == 6) {
                const int f = s == 6, m = l * 2 + f;
                const bool o8 = pg8::is_f8o(m);
                pg8::Gemm g{H, (const bf16_t*)(ws + wfo_off(m)), TP, 1024, o8 ? 1408 : 2816, o8 ? 1408 : 2816}; pg8::StaticOrder S; S.init(TP, 1024, G, (int)blockIdx.x);
                const float* go = f ? p.in[19] + l * 1024 : (l ? p.in[23] + (l - 1) * 1024 : (const float*)(ws + WS_ONE));
                const float* bo = f ? p.in[20] + l * 1024 : (l ? p.in[24] + (l - 1) * 1024 : (const float*)(ws + WS_ZERO));
                const float osc = o8 ? 0.5f / (pg8::F8_HSCALE * pg8::F8_WOSCALE) : 0.5f;
                unsigned char* p8w = (f && l < NL - 1 && pg8::is_f8(2 * l + 2)) ? ws + WS_P8 : nullptr;
                pg8::EpiRes E{P, p8w, ST + (size_t)(f ? 2 + 3 * l : 3 * l) * T_TOK * 8, go, bo, ST + (size_t)(f ? 3 + 3 * l : 1 + 3 * l) * T_TOK * 8, osc, lds + 131072 + 16};
#ifndef NO_RES
                if (o8) pg8::gemm_phase<pg8::EpiRes, pg8::StaticOrder, false, true>(lds, g, S, E, nullptr);
                else pg8::gemm_phase<pg8::EpiRes, pg8::StaticOrder, false, false>(lds, g, S, E, nullptr);
#endif
                sp_A = o8 ? (const bf16_t*)((const unsigned char*)H + (size_t)TP * 2816) : H + (size_t)TP * 2816; sp_B = g.Bt; sp_K = o8 ? 1408 : 2816; sp_go = go; sp_bo = bo; sp_stold = E.st_old; sp_stnew = E.st_new; sp_scale = osc; sp_p8 = p8w; do_split = true;
            } else if (s == 2) {
                pg8::Gemm g{P, (const bf16_t*)(ws + WS_WI + l * SZ_WI), T_TOK, 2304, 1024, 1024}; pg8::StaticOrder S; S.init(T_TOK, 2304, G, (int)blockIdx.x);
                pg8::EpiZ E{H, ST + (size_t)(1 + 3 * l) * T_TOK * 8, (const float*)(ws + WS_CSI) + l * 2304, (const float*)(ws + WS_BWI) + l * 2304, lds + 131072 + 16};
#ifndef NO_Z
                pg8::gemm_phase<pg8::EpiZ, pg8::StaticOrder, false>(lds, g, S, E, nullptr);
#endif
            } else if (s == 3) {
#ifndef NO_MIX
                mixer_phase(lds, l, p);
#endif
            } else {
                pg8::Gemm g{MX, (const bf16_t*)(ws + WS_WO + l * SZ_WO), TP, 1024, 1024, 1024}; pg8::StaticOrder S; S.init(TP, 1024, G, (int)blockIdx.x);
                unsigned char* p8w = pg8::is_f8(2 * l + 1) ? ws + WS_P8 : nullptr;
                pg8::EpiRes E{P, p8w, ST + (size_t)(1 + 3 * l) * T_TOK * 8, p.in[6] + l * 1024, p.in[7] + l * 1024, ST + (size_t)(2 + 3 * l) * T_TOK * 8, 1.0f, lds + 131072 + 16};
#ifndef NO_RES
                pg8::gemm_phase<pg8::EpiRes, pg8::StaticOrder, false>(lds, g, S, E, nullptr);
#endif
                sp_A = MX + (size_t)TP * 1024; sp_B = g.Bt; sp_K = 1024; sp_go = E.g; sp_bo = E.b; sp_stold = E.st_old; sp_stnew = E.st_new; sp_scale = 1.0f; sp_p8 = p8w; do_split = true;
            }
            if (do_split) {
                for (int idx = (int)blockIdx.x - (G >= 64 ? G - 64 : 0); idx >= 0 && idx < 64; idx += G) {
                    const int sp = idx >> 4, tile = idx & 15;
                    const int k0 = sp_K == 2816 ? (sp < 2 ? sp * 768 : 1536 + (sp - 2) * 640) : (sp_K == 1408 ? sp * 384 : sp * 256), kl = sp_K == 2816 ? (sp < 2 ? 768 : 640) : (sp_K == 1408 ? (sp < 3 ? 384 : 256) : 256);
                    pg8::Gemm g2{sp_A + k0, sp_B + k0, 1024, 1024, kl, sp_K}; pg8::SingleUnit S2{tile >> 2, tile & 3};
                    pg8::EpiPart E2{(bf16_t*)(ws + WS_PART) + (size_t)sp * 1048576};
                    if (sp_K == 1408) pg8::gemm_phase<pg8::EpiPart, pg8::SingleUnit, false, true>(lds, g2, S2, E2, nullptr);
                    else pg8::gemm_phase<pg8::EpiPart, pg8::SingleUnit, false, false>(lds, g2, S2, E2, nullptr);
                }
                xcd_barrier(xbar);
                sample_reduce(p, ws, sp_stold, sp_go, sp_bo, sp_stnew, sp_scale, sp_p8);
            }
        }
        if (ph + 1 < p.hi) { if (ph == 0) cg::this_grid().sync(); else xcd_barrier(xbar); }
    }
}

#ifndef N_LAUNCH_MODE
#define N_LAUNCH_MODE 1
#endif
extern "C" void kernel_launch(void* const* d_in, const int* in_sizes, int n_in, void* d_out, int out_size, void* d_ws, size_t ws_size, hipStream_t stream) {
    static int grid = 0;
    if (grid == 0) {
        if (n_in != 25 || ws_size < WS_END) { fprintf(stderr, "kernel_launch: need 25 inputs and %zu bytes of workspace; got %d, %zu\n", (size_t)WS_END, n_in, ws_size); grid = -1; return; }
        int dev = 0, cus = 0, per_cu = 0;
        hipGetDevice(&dev); hipDeviceGetAttribute(&cus, hipDeviceAttributeMultiprocessorCount, dev);
        if (hipFuncSetAttribute((const void*)fwd_kernel, hipFuncAttributeMaxDynamicSharedMemorySize, LDS_BYTES) != hipSuccess) { fprintf(stderr, "kernel_launch: hipFuncSetAttribute failed\n"); grid = -1; return; }
        if (hipOccupancyMaxActiveBlocksPerMultiprocessor(&per_cu, (const void*)fwd_kernel, 512, LDS_BYTES) != hipSuccess || per_cu < 1) { fprintf(stderr, "kernel_launch: occupancy query says %d\n", per_cu); per_cu = 1; }
        (void)hipGetLastError();
        grid = cus * per_cu;
        fprintf(stderr, "kernel_launch: grid %d (cus %d x %d)\n", grid, cus, per_cu);
    }
    if (grid < 0) return;
    if (hipMemsetAsync((char*)d_ws + WS_BAR, 0, 16384, stream) != hipSuccess) { fprintf(stderr, "kernel_launch: memset failed\n"); return; }
    Params p{};
    for (int i = 0; i < 25; ++i) p.in[i] = (const float*)d_in[i];
    p.out = (float*)d_out; p.ws = (unsigned char*)d_ws;
#if N_LAUNCH_MODE == 1
    p.lo = 0; p.hi = N_PHASES;
    void* args[] = {&p};
    hipError_t e = hipLaunchCooperativeKernel((const void*)fwd_kernel, dim3(grid), dim3(512), args, LDS_BYTES, stream);
    if (e != hipSuccess) fprintf(stderr, "cooperative launch failed: %s (grid %d)\n", hipGetErrorString(e), grid);
#else
    for (int ph = 0; ph < N_PHASES; ++ph) {
        p.lo = ph; p.hi = ph + 1;
        hipLaunchKernelGGL(fwd_kernel, dim3(grid), dim3(512), LDS_BYTES, stream, p);
    }
#endif
}
```

```cpp
#include <hip/hip_runtime.h>
#include <hip/hip_cooperative_groups.h>
#include <cstdio>
namespace cg = cooperative_groups;
#ifndef F8_MASK_VALUE
#define F8_MASK_VALUE 0xFCu
#endif
#ifndef F8O_MASK_VALUE
#define F8O_MASK_VALUE 0xFFu
#endif
namespace pg8 {
__device__ __forceinline__ float shx(float v, int o, int lane) { return __int_as_float(__builtin_amdgcn_ds_bpermute((lane ^ o) << 2, __float_as_int(v))); }
__device__ __forceinline__ int opaque_tid() { int t = threadIdx.x; asm volatile("" : "+v"(t)); return t; }
#define PG8_LAS __attribute__((address_space(3)))
typedef unsigned short bf16_t;
typedef short bf16x8 __attribute__((ext_vector_type(8)));
typedef float f32x4 __attribute__((ext_vector_type(4)));
typedef unsigned u32x4 __attribute__((ext_vector_type(4)));
constexpr int BM = 256, BK = 64, HALF = 128, HTB = HALF * BK * 2  , STAGE_BYTES = 8 * HTB, NXCD = 8, WGM = 8;

__host__ __device__ __forceinline__ int lds_byte(int r, int c) { const int st = (r >> 4) * 2 + (c >> 5), rr = r & 15, cc = c & 31, ob = rr * 64 + cc * 2; return st * 1024 + (ob ^ (((ob >> 9) & 1) << 5)); }
__host__ __device__ __forceinline__ void stage_rc(int b, int& R, int& C) { const int st = b / 1024, sb = b % 1024, swz = sb ^ (((sb >> 9) & 1) << 5); R = (st >> 1) * 16 + swz / 64; C = (st & 1) * 32 + (swz % 64) / 2; }
__host__ __device__ __forceinline__ int perm32(int rho) { const int n = rho >> 4, i = rho & 15; return 8 * (i >> 2) + 4 * n + (i & 3); }

struct Unit { int pm, pn, fresh; };
struct Gemm { const bf16_t* A; const bf16_t* Bt; int M, N, K, ld; };

struct StaticOrder {
    int nM, nN, nwg, G, c;
    __host__ __device__ void init(int M, int N, int G_, int c_) { nM = M / BM; nN = N / BM; nwg = nM * nN; G = G_; c = c_; }
    __host__ __device__ bool next(int i, Unit& u) const {
        const long L = (long)i * G + c; if (L >= nwg) return false;
        int wgid = (int)L; { const int q = nwg / NXCD, r = nwg % NXCD, xcd = wgid % NXCD, off = wgid / NXCD; wgid = (xcd < r ? xcd * (q + 1) : r * (q + 1) + (xcd - r) * q) + off; }
        const int nig = WGM * nN, gid = wgid / nig, fm = gid * WGM, gsz = (nM - fm) < WGM ? (nM - fm) : WGM;
        u.pm = fm + ((wgid % nig) % gsz); u.pn = (wgid % nig) / gsz; return true;
    }
    __device__ __forceinline__ void a_ready(const Unit&) const {}
    __device__ __forceinline__ void done(const Unit&) const {}
};

__device__ __forceinline__ unsigned cvt_pk_bf16(float lo, float hi) { unsigned r; asm volatile("v_cvt_pk_bf16_f32 %0, %1, %2" : "=v"(r) : "v"(lo), "v"(hi)); return r; }
__device__ __forceinline__ float bf_lo(unsigned w) { return __uint_as_float(w << 16); }
__device__ __forceinline__ float bf_hi(unsigned w) { return __uint_as_float(w & 0xffff0000u); }
typedef unsigned u32x2v __attribute__((ext_vector_type(2)));
typedef int i32x8 __attribute__((ext_vector_type(8)));
typedef int i32x4v __attribute__((ext_vector_type(4)));
__device__ __forceinline__ unsigned f8x4(float a, float b, float c, float d) {
    a = __builtin_fminf(__builtin_fmaxf(a, -448.f), 448.f); b = __builtin_fminf(__builtin_fmaxf(b, -448.f), 448.f); c = __builtin_fminf(__builtin_fmaxf(c, -448.f), 448.f); d = __builtin_fminf(__builtin_fmaxf(d, -448.f), 448.f);
    int r = __builtin_amdgcn_cvt_pk_fp8_f32(a, b, 0, false); r = __builtin_amdgcn_cvt_pk_fp8_f32(c, d, r, true); return (unsigned)r; }
constexpr unsigned F8_MASK = F8_MASK_VALUE;
__host__ __device__ constexpr bool is_f8(int m) { return (F8_MASK >> m) & 1u; }
constexpr unsigned F8O_MASK = F8O_MASK_VALUE;
__host__ __device__ constexpr bool is_f8o(int m) { return (F8O_MASK >> m) & 1u; }
constexpr float F8_HSCALE = 4.0f, F8_WOSCALE = 256.0f;
constexpr float F8_WSCALE = 64.0f;
constexpr float LN_EPS_F = 1e-5f;
constexpr float ALPHA_F = 1.6817928305074290f;
typedef float f32x2 __attribute__((ext_vector_type(2)));
__device__ __forceinline__ void stats_of(const f32x4 a, const f32x4 b, float& mu, float& rstd) {
    const float sx = (a[0] + a[2]) + (b[0] + b[2]), sy = (a[1] + a[3]) + (b[1] + b[3]);
    mu = sx * (1.0f / 1024.0f); const float var = sy * (1.0f / 1024.0f) - mu * mu; rstd = rsqrtf(var + LN_EPS_F);
}
__device__ __forceinline__ void row_stats(const float* st, int r, float& mu, float& rstd) {
    const f32x4 a = *(const f32x4*)(st + 8 * (size_t)r), b = *(const f32x4*)(st + 8 * (size_t)r + 4); stats_of(a, b, mu, rstd);
}
__device__ __forceinline__ void stats_tab_fill(PG8_LAS unsigned char* scr, const float* st, const Unit& u, int wr, int wc, int fr, int fq) {
    if (u.fresh) {
        const int lane = fq * 16 + fr;
        if (lane < 32) { const int ri = wc * 32 + lane, r = u.pm * BM + (ri >> 6) * HALF + wr * 64 + (ri & 63); float mu, rstd; row_stats(st, r, mu, rstd);
            *(PG8_LAS f32x2*)(scr + (wr * 128 + ri) * 8) = (f32x2){mu, rstd}; }
        asm volatile("s_waitcnt lgkmcnt(0)" ::: "memory"); __builtin_amdgcn_s_barrier(); asm volatile("" ::: "memory");
    }
}
__device__ __forceinline__ float silu_f(float g) { return g * __builtin_amdgcn_rcpf(1.0f + __expf(-g)); }
__device__ __forceinline__ float sigmoid_f(float g) { return __builtin_amdgcn_rcpf(1.0f + __expf(-g)); }

struct EpiSwiGLU {
    static constexpr bool PERM = true, AFTER_DRAIN = false;
    bf16_t* H; const float* st; const float* cs; const float* bw; float ascale; float hscale; PG8_LAS unsigned char* scr;
    __device__ __forceinline__ void operator()(const f32x4 (&acc)[2][2][4][2], const Unit& u, int wr, int wc, int fr, int fq) const {
        const int row0 = u.pm * BM + wr * 64 + fr;
        stats_tab_fill(scr, st, u, wr, wc, fr, fq);
        const int nb = u.pn * BM + wc * 32 + 8 * fq;
        const int hc = u.pn * 128 + wc * 32 + 8 * fq;
        f32x4 csg[2], bwg[2], csu[2], bwu[2];
#pragma unroll
        for (int n = 0; n < 2; ++n) { csg[n] = *(const f32x4*)(cs + nb + 4 * n); bwg[n] = *(const f32x4*)(bw + nb + 4 * n); csu[n] = *(const f32x4*)(cs + nb + 128 + 4 * n); bwu[n] = *(const f32x4*)(bw + nb + 128 + 4 * n); }
#pragma unroll
        for (int ai = 0; ai < 2; ++ai)
#pragma unroll
            for (int m = 0; m < 4; ++m) {
                const int r = row0 + ai * HALF + m * 16; const f32x2 mr_ = *(const PG8_LAS f32x2*)(scr + (wr * 128 + ai * 64 + m * 16 + fr) * 8); const float mu = mr_[0], rstd = mr_[1];
                float h[8];
#pragma unroll
                for (int n = 0; n < 2; ++n) {
                    const f32x4 g = (acc[ai][0][m][n] * ascale - mu * csg[n]) * rstd + bwg[n];
                    const f32x4 up = (acc[ai][1][m][n] * ascale - mu * csu[n]) * rstd + bwu[n];
                    const f32x4 t = g * (-1.4426950408889634f); f32x4 e;
#pragma unroll
                    for (int j = 0; j < 4; ++j) e[j] = __builtin_amdgcn_exp2f(t[j]);
                    const f32x4 d = e + 1.0f; f32x4 rc;
#pragma unroll
                    for (int j = 0; j < 4; ++j) rc[j] = __builtin_amdgcn_rcpf(d[j]);
                    const f32x4 o = (g * up) * rc;
#pragma unroll
                    for (int j = 0; j < 4; ++j) h[4 * n + j] = o[j];
                }
                if (hscale != 0.f) {
                    *(u32x2v*)((unsigned char*)H + (size_t)r * 2816 + hc) = (u32x2v){f8x4(h[0] * hscale, h[1] * hscale, h[2] * hscale, h[3] * hscale), f8x4(h[4] * hscale, h[5] * hscale, h[6] * hscale, h[7] * hscale)};
                } else {
                u32x4 w; w.x = cvt_pk_bf16(h[0], h[1]); w.y = cvt_pk_bf16(h[2], h[3]); w.z = cvt_pk_bf16(h[4], h[5]); w.w = cvt_pk_bf16(h[6], h[7]);
                *(u32x4*)(H + (size_t)r * 2816 + hc) = w;
                }
            }
    }
};
struct EpiNone { static constexpr bool PERM = true, AFTER_DRAIN = false; float* sink;
    __device__ __forceinline__ void operator()(const f32x4 (&acc)[2][2][4][2], const Unit& u, int wr, int wc, int fr, int fq) const {
        float t = 0.f;
#pragma unroll
        for (int ai = 0; ai < 2; ++ai)
#pragma unroll
            for (int bj = 0; bj < 2; ++bj)
#pragma unroll
                for (int m = 0; m < 4; ++m)
#pragma unroll
                    for (int n = 0; n < 2; ++n) t += acc[ai][bj][m][n][0] + acc[ai][bj][m][n][1] + acc[ai][bj][m][n][2] + acc[ai][bj][m][n][3];
        if (t == 123.456f) sink[0] = t; } };
struct EpiPart {
    static constexpr bool PERM = true, AFTER_DRAIN = false;
    bf16_t* part;
    __device__ __forceinline__ void operator()(const f32x4 (&acc)[2][2][4][2], const Unit& u, int wr, int wc, int fr, int fq) const {
        const int row0 = u.pm * BM + wr * 64 + fr, c0 = u.pn * BM + wc * 32 + 8 * fq;
#pragma unroll
        for (int ai = 0; ai < 2; ++ai)
#pragma unroll
            for (int m = 0; m < 4; ++m)
#pragma unroll
                for (int bj = 0; bj < 2; ++bj) { const f32x4 v0 = acc[ai][bj][m][0], v1 = acc[ai][bj][m][1];
                    u32x4 w; w.x = cvt_pk_bf16(v0[0], v0[1]); w.y = cvt_pk_bf16(v0[2], v0[3]); w.z = cvt_pk_bf16(v1[0], v1[1]); w.w = cvt_pk_bf16(v1[2], v1[3]);
                    *(u32x4*)((char*)part + (unsigned)((row0 + ai * HALF + m * 16) * 2048 + (c0 + bj * HALF) * 2)) = w; }
    }
};
struct SingleUnit { int pm, pn;
    __device__ __forceinline__ bool next(int i, Unit& u) const { if (i != 0) return false; u.pm = pm; u.pn = pn; return true; }
    __device__ __forceinline__ void a_ready(const Unit&) const {}
    __device__ __forceinline__ void done(const Unit&) const {}
};
struct EpiZ {
    static constexpr bool PERM = true, AFTER_DRAIN = false;
    bf16_t* Z; const float* st; const float* cs; const float* bw; PG8_LAS unsigned char* scr;
    __device__ __forceinline__ void operator()(const f32x4 (&acc)[2][2][4][2], const Unit& u, int wr, int wc, int fr, int fq) const {
        const int row0 = u.pm * BM + wr * 64 + fr;
        stats_tab_fill(scr, st, u, wr, wc, fr, fq);
        const int c0 = u.pn * BM + wc * 32 + 8 * fq;
        f32x4 csv[2][2], bwv[2][2];
#pragma unroll
        for (int bj = 0; bj < 2; ++bj)
#pragma unroll
            for (int n = 0; n < 2; ++n) { csv[bj][n] = *(const f32x4*)(cs + c0 + bj * HALF + 4 * n); bwv[bj][n] = *(const f32x4*)(bw + c0 + bj * HALF + 4 * n); }
#pragma unroll
        for (int ai = 0; ai < 2; ++ai)
#pragma unroll
            for (int m = 0; m < 4; ++m) {
                const int r = row0 + ai * HALF + m * 16; const f32x2 mr_ = *(const PG8_LAS f32x2*)(scr + (wr * 128 + ai * 64 + m * 16 + fr) * 8); const float mu = mr_[0], rstd = mr_[1];
#pragma unroll
                for (int bj = 0; bj < 2; ++bj) {
                    const f32x4 v0 = (acc[ai][bj][m][0] - mu * csv[bj][0]) * rstd + bwv[bj][0];
                    const f32x4 v1 = (acc[ai][bj][m][1] - mu * csv[bj][1]) * rstd + bwv[bj][1];
                    u32x4 w; w.x = cvt_pk_bf16(v0[0], v0[1]); w.y = cvt_pk_bf16(v0[2], v0[3]); w.z = cvt_pk_bf16(v1[0], v1[1]); w.w = cvt_pk_bf16(v1[2], v1[3]);
                    *(u32x4*)(Z + (size_t)r * 2304 + c0 + bj * HALF) = w;
                }
            }
    }
};
struct EpiRes {
    static constexpr bool PERM = true, AFTER_DRAIN = false;
    bf16_t* P; unsigned char* P8; const float* st_old; const float* g; const float* b; float* st_new; float scale; PG8_LAS unsigned char* scr;
    __device__ __forceinline__ void operator()(const f32x4 (&acc)[2][2][4][2], const Unit& u, int wr, int wc, int fr, int fq) const {
        const int row0 = u.pm * BM + wr * 64 + fr;
        const int c0 = u.pn * BM + wc * 32 + 8 * fq;
        f32x4 gv[2][2], bv[2][2];
#pragma unroll
        for (int bj = 0; bj < 2; ++bj)
#pragma unroll
            for (int n = 0; n < 2; ++n) { gv[bj][n] = *(const f32x4*)(g + c0 + bj * HALF + 4 * n); bv[bj][n] = *(const f32x4*)(b + c0 + bj * HALF + 4 * n) * ALPHA_F; }
#pragma unroll
        for (int hh = 0; hh < 4; ++hh) {
            const int ai = hh >> 1;
            u32x4 pw[4][2]; f32x4 sva[4], svb[4];
#pragma unroll
            for (int m = (hh & 1) * 2; m < (hh & 1) * 2 + 2; ++m) { const int r = row0 + ai * HALF + m * 16; sva[m] = *(const f32x4*)((const char*)st_old + (unsigned)(r * 32)); svb[m] = *(const f32x4*)((const char*)st_old + (unsigned)(r * 32 + 16));
#pragma unroll
                for (int bj = 0; bj < 2; ++bj) pw[m][bj] = *(const u32x4*)((const char*)P + (unsigned)(r * 2048 + (c0 + bj * HALF) * 2)); }
#pragma unroll
            for (int m = (hh & 1) * 2; m < (hh & 1) * 2 + 2; ++m) {
                const int r = row0 + ai * HALF + m * 16;
                float mu, rs; stats_of(sva[m], svb[m], mu, rs); rs *= ALPHA_F;
                float s = 0.f, ss = 0.f;
#pragma unroll
                for (int bj = 0; bj < 2; ++bj) {
                    const int c = c0 + bj * HALF; const u32x4 w0 = pw[m][bj];
                    f32x4 x0, x1;
                    x0[0] = bf_lo(w0.x); x0[1] = bf_hi(w0.x); x0[2] = bf_lo(w0.y); x0[3] = bf_hi(w0.y);
                    x1[0] = bf_lo(w0.z); x1[1] = bf_hi(w0.z); x1[2] = bf_lo(w0.w); x1[3] = bf_hi(w0.w);
                    f32x4 v0 = ((x0 - mu) * rs) * gv[bj][0] + (bv[bj][0] + scale * acc[ai][bj][m][0]);
                    f32x4 v1 = ((x1 - mu) * rs) * gv[bj][1] + (bv[bj][1] + scale * acc[ai][bj][m][1]);
                    {
                        u32x4 w; w.x = cvt_pk_bf16(v0[0], v0[1]); w.y = cvt_pk_bf16(v0[2], v0[3]); w.z = cvt_pk_bf16(v1[0], v1[1]); w.w = cvt_pk_bf16(v1[2], v1[3]);
                        *(u32x4*)((char*)P + (unsigned)(r * 2048 + c * 2)) = w;
                        if (P8) *(u32x2v*)(P8 + (unsigned)(r * 1024 + c)) = (u32x2v){f8x4(v0[0], v0[1], v0[2], v0[3]), f8x4(v1[0], v1[1], v1[2], v1[3])};
                        v0[0] = bf_lo(w.x); v0[1] = bf_hi(w.x); v0[2] = bf_lo(w.y); v0[3] = bf_hi(w.y);
                        v1[0] = bf_lo(w.z); v1[1] = bf_hi(w.z); v1[2] = bf_lo(w.w); v1[3] = bf_hi(w.w);
                    }
                    s += (v0[0] + v0[1]) + (v0[2] + v0[3]) + (v1[0] + v1[1]) + (v1[2] + v1[3]);
                    ss += (v0[0] * v0[0] + v0[1] * v0[1]) + (v0[2] * v0[2] + v0[3] * v0[3]) + (v1[0] * v1[0] + v1[1] * v1[1]) + (v1[2] * v1[2] + v1[3] * v1[3]);
                }
                { const int ln = fq * 16 + fr; s += shx(s, 16, ln); s += shx(s, 32, ln); ss += shx(ss, 16, ln); ss += shx(ss, 32, ln); }
                if (fq == 0) *(PG8_LAS f32x2*)(scr + (((wr * 4 + wc) * 128) + ai * 64 + m * 16 + fr) * 8) = (f32x2){s, ss};
            }
            asm volatile("" ::: "memory");
        }
        asm volatile("s_waitcnt lgkmcnt(0)" ::: "memory"); __builtin_amdgcn_s_barrier(); asm volatile("" ::: "memory");
        const int lane = fq * 16 + fr;
        if (lane < 32) {
            const int ri = wc * 32 + lane;
            const PG8_LAS unsigned char* q = scr + (wr * 4 * 128 + ri) * 8;
            const f32x2 p0 = *(const PG8_LAS f32x2*)q, p1 = *(const PG8_LAS f32x2*)(q + 1024), p2 = *(const PG8_LAS f32x2*)(q + 2048), p3 = *(const PG8_LAS f32x2*)(q + 3072);
            const int r = u.pm * BM + (ri >> 6) * HALF + wr * 64 + (ri & 63);
            *(f32x2*)((char*)st_new + (unsigned)(r * 32 + 8 * u.pn)) = (f32x2){(p0[0] + p1[0]) + (p2[0] + p3[0]), (p0[1] + p1[1]) + (p2[1] + p3[1])};
        }
    }
};

template <class Epi, class Sched, bool STAMP = false, bool F8 = false>
__device__ __forceinline__ void gemm_phase(PG8_LAS unsigned char* lds, const Gemm g, const Sched& S, const Epi& E, unsigned long long* stamps) {
    const int tid = opaque_tid(), wid = __builtin_amdgcn_readfirstlane(tid >> 6), lane = tid & 63, wr = wid >> 2, wc = wid & 3, fr = lane & 15, fq = lane >> 4;
    const int K = g.ld, nt = g.K / BK;
    int ts_lo = 0, ts_hi = 0, nts = 0; const unsigned long long rt_entry = STAMP ? (unsigned long long)wall_clock64() : 0ull;
#define PG8_STAMP() do { if (STAMP && wid == 0 && nts < 64) { const unsigned long long _c = (unsigned long long)clock64(); \
        ts_lo = (lane == nts) ? (int)(unsigned)_c : ts_lo; ts_hi = (lane == nts) ? (int)(unsigned)(_c >> 32) : ts_hi; ++nts; } } while (0)
    PG8_STAMP();
    unsigned voffA[2], voffB[2];
#pragma unroll
    for (int i = 0; i < 2; ++i) { int R, C; stage_rc(tid * 16 + i * 8192, R, C); const int Rb = Epi::PERM ? ((R & ~31) + perm32(R & 31)) : R;
        voffA[i] = (unsigned)(R * K + C) * 2u; voffB[i] = (unsigned)(Rb * K + C) * 2u; }
    const size_t kstep = (size_t)(BK * 2);
    const size_t hstep = (size_t)HALF * K * 2;
    const size_t tstep = 2 * hstep;
    const unsigned ldsw = (unsigned)wid * 1024u;
    const int aoff = lds_byte(wr * 64 + fr, fq * 8), boff = lds_byte(wc * 32 + fr, fq * 8);
#define PG8_SA(b, h) (((b) * 2 + (h)) * HTB)
#define PG8_SB(b, h) ((4 + (b) * 2 + (h)) * HTB)
#define PG8_STAGE(bufoff, gbase, voff) do { _Pragma("unroll") for (int _i = 0; _i < 2; ++_i) \
        __builtin_amdgcn_global_load_lds((const unsigned*)((const char*)(gbase) + (voff)[_i]), (PG8_LAS unsigned*)(lds + (bufoff) + ldsw + _i * 8192), 16, 0, 0); } while (0)
#define PG8_LDA(dst, b, h) do { _Pragma("unroll") for (int m = 0; m < 4; ++m) { if constexpr (F8) { \
            const i32x4v lo_ = *(const PG8_LAS i32x4v*)(lds + PG8_SA(b, h) + aoff + m * 2048), hi_ = *(const PG8_LAS i32x4v*)(lds + PG8_SA(b, h) + aoff + m * 2048 + 1024); \
            dst##8[m] = __builtin_shufflevector(lo_, hi_, 0, 1, 2, 3, 4, 5, 6, 7); } else { \
        _Pragma("unroll") for (int k = 0; k < 2; ++k) dst[m][k] = *(const PG8_LAS bf16x8*)(lds + PG8_SA(b, h) + aoff + m * 2048 + k * 1024); } } } while (0)
#define PG8_LDB(dst, b, h) do { _Pragma("unroll") for (int n = 0; n < 2; ++n) { if constexpr (F8) { \
            const i32x4v lo_ = *(const PG8_LAS i32x4v*)(lds + PG8_SB(b, h) + boff + n * 2048), hi_ = *(const PG8_LAS i32x4v*)(lds + PG8_SB(b, h) + boff + n * 2048 + 1024); \
            dst##8[n] = __builtin_shufflevector(lo_, hi_, 0, 1, 2, 3, 4, 5, 6, 7); } else { \
        _Pragma("unroll") for (int k = 0; k < 2; ++k) dst[n][k] = *(const PG8_LAS bf16x8*)(lds + PG8_SB(b, h) + boff + n * 2048 + k * 1024); } } } while (0)
#define PG8_MMA(ai, bj, At, Bt) do { __builtin_amdgcn_s_setprio(1); _Pragma("unroll") for (int m = 0; m < 4; ++m) _Pragma("unroll") for (int n = 0; n < 2; ++n) { \
        if constexpr (F8) {   \
            asm volatile("v_mfma_scale_f32_16x16x128_f8f6f4 %0, %1, %2, %0, %3, %3 op_sel_hi:[0,0,0]" : "+v"(acc[ai][bj][m][n]) : "v"(Bt##8[n]), "v"(At##8[m]), "v"(f8sc));   \
        } else { _Pragma("unroll") for (int k = 0; k < 2; ++k) \
        acc[ai][bj][m][n] = __builtin_amdgcn_mfma_f32_16x16x32_bf16(Bt[n][k], At[m][k], acc[ai][bj][m][n], 0, 0, 0); } } __builtin_amdgcn_s_setprio(0); } while (0)
#define PG8_WAIT_V(n) asm volatile("s_waitcnt vmcnt(" #n ")" ::: "memory")
#define PG8_WAIT_L(n) asm volatile("s_waitcnt lgkmcnt(" #n ")" ::: "memory")
#define PG8_BAR __builtin_amdgcn_s_barrier()
#define PG8_SCHED __builtin_amdgcn_sched_barrier(0)
    Unit cur, nxt; int ui = 0; int prevpm = -1;
    if (!S.next(0, cur)) return;
    f32x4 acc[2][2][4][2];
#pragma unroll
    for (int a = 0; a < 2; ++a)
#pragma unroll
        for (int b = 0; b < 2; ++b)
#pragma unroll
            for (int m = 0; m < 4; ++m)
#pragma unroll
                for (int n = 0; n < 2; ++n) acc[a][b][m][n] = (f32x4){0.f, 0.f, 0.f, 0.f};
    const int f8sc = 0x7F7F7F7F;
    bf16x8 At[4][2], B0[2][2], B1[2][2]; i32x8 At8[4], B08[2], B18[2];
    const char* cA = (const char*)g.A + (size_t)cur.pm * tstep; const char* cB = (const char*)g.Bt + (size_t)cur.pn * tstep;
    S.a_ready(cur);
    PG8_STAGE(PG8_SB(0, 0), cB, voffB); PG8_STAGE(PG8_SA(0, 0), cA, voffA); PG8_STAGE(PG8_SB(0, 1), cB + hstep, voffB); PG8_STAGE(PG8_SA(0, 1), cA + hstep, voffA);
    if (wr == 1) PG8_BAR;
    PG8_WAIT_V(4); PG8_BAR;
    PG8_STAGE(PG8_SB(1, 0), cB + kstep, voffB); PG8_STAGE(PG8_SA(1, 0), cA + kstep, voffA); PG8_STAGE(PG8_SB(1, 1), cB + hstep + kstep, voffB);
    PG8_WAIT_V(6); PG8_BAR;
    PG8_STAMP();
    for (;;) {
        const bool has_next = S.next(ui + 1, nxt);
        const char* nA = has_next ? (const char*)g.A + (size_t)nxt.pm * tstep : cA; const char* nB = has_next ? (const char*)g.Bt + (size_t)nxt.pn * tstep : cB;
        for (int t = 0; t < nt; t += 2) {
            const bool last = (t == nt - 2);
            const char* a1 = cA + (size_t)(t + 1) * kstep;
            const char* a2 = last ? nA : cA + (size_t)(t + 2) * kstep; const char* b2 = last ? nB : cB + (size_t)(t + 2) * kstep;
            const char* a3 = a2 + kstep; const char* b3 = b2 + kstep;
            if (last && has_next) S.a_ready(nxt);
            PG8_LDB(B0, 0, 0); PG8_SCHED; PG8_LDA(At, 0, 0); PG8_STAGE(PG8_SA(1, 1), a1 + hstep, voffA);
            PG8_WAIT_L(8); PG8_BAR; PG8_WAIT_L(0); PG8_MMA(0, 0, At, B0); PG8_BAR; PG8_SCHED;
            PG8_LDB(B1, 0, 1); PG8_STAGE(PG8_SB(0, 0), b2, voffB);
            PG8_WAIT_V(10); PG8_BAR; PG8_WAIT_L(0); PG8_MMA(0, 1, At, B1); PG8_BAR;
            PG8_LDA(At, 0, 1); PG8_STAGE(PG8_SA(0, 0), a2, voffA);
            PG8_BAR; PG8_WAIT_L(0); PG8_MMA(1, 0, At, B0); PG8_BAR; PG8_SCHED;
            PG8_STAGE(PG8_SB(0, 1), b2 + hstep, voffB);
            PG8_WAIT_V(8); PG8_BAR; PG8_MMA(1, 1, At, B1); PG8_BAR;
            PG8_LDB(B0, 1, 0); PG8_SCHED; PG8_LDA(At, 1, 0); PG8_STAGE(PG8_SA(0, 1), a2 + hstep, voffA);
            PG8_WAIT_L(8); PG8_BAR; PG8_WAIT_L(0); PG8_MMA(0, 0, At, B0); PG8_BAR; PG8_SCHED;
            PG8_LDB(B1, 1, 1); PG8_STAGE(PG8_SB(1, 0), b3, voffB);
            PG8_WAIT_V(10); PG8_BAR; PG8_WAIT_L(0); PG8_MMA(0, 1, At, B1); PG8_BAR;
            PG8_LDA(At, 1, 1); PG8_STAGE(PG8_SA(1, 0), a3, voffA);
            PG8_BAR; PG8_WAIT_L(0); PG8_MMA(1, 0, At, B0); PG8_BAR; PG8_SCHED;
            PG8_STAGE(PG8_SB(1, 1), b3 + hstep, voffB);
            PG8_WAIT_V(8); PG8_BAR; PG8_MMA(1, 1, At, B1); PG8_BAR;
        }
        PG8_STAMP();
        if constexpr (F8) asm volatile("s_nop 15\n\ts_nop 15" ::: "memory");
        cur.fresh = (cur.pm != prevpm); prevpm = cur.pm;
        if constexpr (!Epi::AFTER_DRAIN) { E(acc, cur, wr, wc, fr, fq); S.done(cur); }
        PG8_STAMP();
        if (!has_next) break;
#pragma unroll
        for (int a = 0; a < 2; ++a)
#pragma unroll
            for (int b = 0; b < 2; ++b)
#pragma unroll
                for (int m = 0; m < 4; ++m)
#pragma unroll
                    for (int n = 0; n < 2; ++n) acc[a][b][m][n] = (f32x4){0.f, 0.f, 0.f, 0.f};
        cur = nxt; cA = nA; cB = nB; ++ui;
    }
    PG8_WAIT_V(0);
    if (wr == 0) PG8_BAR;
    PG8_BAR;
    if constexpr (Epi::AFTER_DRAIN) { E.fused(acc, cur, wr, wc, fr, fq, lds, wid, lane); S.done(cur); }
    PG8_STAMP();
    if (STAMP && wid == 0) { stamps[lane] = lane < nts ? (((unsigned long long)(unsigned)ts_hi << 32) | (unsigned)ts_lo) : 0ull;
        if (lane == 62) stamps[62] = rt_entry; if (lane == 63) stamps[63] = (unsigned long long)wall_clock64(); }
#undef PG8_STAMP
#undef PG8_SA
#undef PG8_SB
#undef PG8_STAGE
#undef PG8_LDA
#undef PG8_LDB
#undef PG8_MMA
#undef PG8_WAIT_V
#undef PG8_WAIT_L
#undef PG8_BAR
#undef PG8_SCHED
}
}

#define XB_TMO      128
#define XB_XCNT(j)  (256  + 64 * (j))
#define XB_XSUB(j)  (1280 + 64 * (j))
#define XB_XGEN(j)  (2304 + 64 * (j))
#define XB_TOP      3328
#define XB_TOPGEN   3392
#define XCD_BAR_WORDS 3456
#define XB_SPIN_CAP (1u << 18)
#define LAS __attribute__((address_space(3)))

__device__ __forceinline__ unsigned xb_ld(unsigned* p)              { return __hip_atomic_load(p, __ATOMIC_RELAXED, __HIP_MEMORY_SCOPE_AGENT); }
__device__ __forceinline__ unsigned xb_add(unsigned* p, unsigned v) { return __hip_atomic_fetch_add(p, v, __ATOMIC_RELAXED, __HIP_MEMORY_SCOPE_AGENT); }
__device__ __forceinline__ unsigned xb_xcc_id() { return (unsigned)__builtin_amdgcn_s_getreg((3 << 11) | 20) & 0xFu; }
#define XB_SPIN(cond, bar) do { unsigned _sp = 0; while (cond) { __builtin_amdgcn_s_sleep(1); \
    if ((++_sp & 255u) == 0u) { if (xb_ld(&(bar)[XB_TMO])) break; if (_sp > XB_SPIN_CAP) { atomicAdd(&(bar)[XB_TMO], 1u); break; } } } } while (0)

struct XcdBarrier {
    unsigned* bar; unsigned x;
    volatile LAS unsigned* st;
};

__device__ __forceinline__ XcdBarrier xcd_barrier_post(unsigned* bar, volatile LAS unsigned* st) {
    XcdBarrier b; b.bar = bar; b.x = xb_xcc_id(); b.st = st;
    if (threadIdx.x == 0) (void)xb_add(&bar[XB_XCNT(b.x)], 1u);
    return b;
}
__device__ __forceinline__ void xcd_barrier_complete(unsigned* bar, unsigned x, unsigned& nloc, unsigned& nx) {
    const unsigned G = gridDim.x * gridDim.y * gridDim.z;
    unsigned sum, cnt, mine, sp = 0u;
    for (;;) {
        sum = 0u; cnt = 0u; mine = 0u;
#pragma unroll
        for (unsigned j = 0; j < 16; ++j) { const unsigned c = xb_ld(&bar[XB_XCNT(j)]); sum += c; cnt += (c > 0u) ? 1u : 0u; mine = (j == x) ? c : mine; }
        if (sum == G) break;
        __builtin_amdgcn_s_sleep(1);
        if ((++sp & 255u) == 0u) { if (xb_ld(&bar[XB_TMO])) break; if (sp > XB_SPIN_CAP) { atomicAdd(&bar[XB_TMO], 1u); break; } }
    }
    nloc = mine > 0u ? mine : 1u; nx = cnt > 0u ? cnt : 1u;
}

__device__ __forceinline__ void xcd_barrier(const XcdBarrier& b) {
    asm volatile("s_waitcnt vmcnt(0)" ::: "memory");
    __syncthreads();
    if (threadIdx.x == 0) {
        unsigned* bar = b.bar;
        __builtin_amdgcn_s_waitcnt(0);
        unsigned nloc = b.st[0], nx = b.st[1];
        if (nloc == 0u) { xcd_barrier_complete(bar, b.x, nloc, nx); b.st[0] = nloc; b.st[1] = nx; }
        const unsigned old = xb_add(&bar[XB_XSUB(b.x)], 1u);
        const unsigned gen = old / nloc;
        if (old + 1u == (gen + 1u) * nloc) {
            __builtin_amdgcn_fence(__ATOMIC_RELEASE, "agent");
            asm volatile("s_waitcnt vmcnt(0)" ::: "memory");
            const unsigned og = xb_add(&bar[XB_TOP], 1u);
            const unsigned tg = og / nx;
            if (og + 1u == (tg + 1u) * nx) xb_add(&bar[XB_TOPGEN], 1u);
            else XB_SPIN(xb_ld(&bar[XB_TOPGEN]) == tg, bar);
            __builtin_amdgcn_fence(__ATOMIC_ACQUIRE, "agent");
            xb_add(&bar[XB_XGEN(b.x)], 1u);
            asm volatile("s_waitcnt vmcnt(0)" ::: "memory");
        } else {
            XB_SPIN(xb_ld(&bar[XB_XGEN(b.x)]) == gen, bar);
            __builtin_amdgcn_fence(__ATOMIC_ACQUIRE, "agent");
            asm volatile("s_waitcnt vmcnt(0)" ::: "memory");
        }
    }
    __syncthreads();
}


using pg8::bf16_t; using pg8::f32x4; using pg8::u32x4; using pg8::bf16x8;
using pg8::cvt_pk_bf16; using pg8::bf_lo; using pg8::bf_hi; using pg8::silu_f; using pg8::sigmoid_f; using pg8::LN_EPS_F;
typedef unsigned u32x2 __attribute__((ext_vector_type(2)));
constexpr int T_TOK = 33792, TP = 32768, NL = 4;
constexpr size_t SZ_WFI = (size_t)5632 * 1024 * 2, SZ_WFO = (size_t)1024 * 2816 * 2, SZ_WI = (size_t)2304 * 1024 * 2, SZ_WO = (size_t)1024 * 1024 * 2;
constexpr size_t WS_WFI = 0;
constexpr size_t SZ_WFI8 = (size_t)5632 * 1024;
constexpr size_t WS_P8 = WS_WFI;
static_assert(F8O_MASK_VALUE == 0xFFu, "the weight placement below needs every FFN-out matrix in e4m3 (it reuses the second half of their region)");
__host__ __device__ constexpr size_t wfi_off(int m) {
    int n8 = 0, i8 = 0, i16 = 0;
    for (int j = 0; j < 8; ++j) { const bool f = (F8_MASK_VALUE >> j) & 1u; n8 += f; if (j < m) { i8 += f; i16 += !f; } }
    const size_t base8 = WS_WFI + (size_t)33792 * 1024, base16 = base8 + (size_t)n8 * SZ_WFI8;
    const int cap = (int)((WS_WFI + 8 * SZ_WFI - base16) / SZ_WFI);
    if ((F8_MASK_VALUE >> m) & 1u) return base8 + (size_t)i8 * SZ_WFI8;
    return i16 < cap ? base16 + (size_t)i16 * SZ_WFI : WS_WFI + 8 * SZ_WFI + 4 * SZ_WFO + (size_t)(i16 - cap) * SZ_WFI;
}
constexpr bool wfi_layout_ok() { int n8 = 0; for (int j = 0; j < 8; ++j) n8 += (F8_MASK_VALUE >> j) & 1u;
    const size_t base16 = WS_WFI + (size_t)33792 * 1024 + (size_t)n8 * SZ_WFI8; const int cap = (int)((WS_WFI + 8 * SZ_WFI - base16) / SZ_WFI); return (8 - n8) - cap <= 2 && base16 <= WS_WFI + 8 * SZ_WFI; }
static_assert(wfi_layout_ok(), "FFN-in weight placement does not fit");
__host__ __device__ constexpr size_t wfo_off(int m) { return WS_WFI + 8 * SZ_WFI + (size_t)m * (SZ_WFO / 2); }
constexpr size_t WS_WFO = WS_WFI + 8 * SZ_WFI;
constexpr size_t WS_WI = WS_WFO + 8 * SZ_WFO;
constexpr size_t WS_WO = WS_WI + 4 * SZ_WI;
constexpr size_t WS_CSF = WS_WO + 4 * SZ_WO;
constexpr size_t WS_BWF = WS_CSF + 8 * 5632 * 4;
constexpr size_t WS_CSI = WS_BWF + 8 * 5632 * 4;
constexpr size_t WS_BWI = WS_CSI + 4 * 2304 * 4;
constexpr size_t WS_ONE = WS_BWI + 4 * 2304 * 4;
constexpr size_t WS_ZERO = WS_ONE + 4096;
constexpr size_t WS_ST = WS_ZERO + 4096;
constexpr size_t SZ_ST = (size_t)T_TOK * 32;
constexpr size_t WS_P = WS_ST + 13 * SZ_ST;
constexpr size_t WS_H = WS_P + (size_t)T_TOK * 1024 * 2;
constexpr size_t WS_MX = WS_H + (size_t)T_TOK * 2816 * 2;
constexpr size_t WS_BAR = WS_MX + (size_t)T_TOK * 1024 * 2;
constexpr size_t WS_PART = WS_BAR + 16384;
constexpr size_t WS_END = WS_PART + (size_t)4 * 1024 * 1024 * 4;
constexpr size_t O_SAP = 34603008, O_SCP = 34787328, O_SAS = 34795520, O_SCS = 35532800, O_SVS = 35565568;
constexpr int LDS_BYTES = 131072 + 16 + 8192;
constexpr int N_PHASES = 30;

#ifndef PROBE_REP
#define PROBE_REP 0
#endif
struct Params { const float* in[25]; float* out; unsigned char* ws; int lo, hi; };

__device__ __forceinline__ unsigned short f2bf(float f) { unsigned u = __float_as_uint(f); u += 0x7FFFu + ((u >> 16) & 1u); return (unsigned short)(u >> 16); }
__device__ __forceinline__ float bf2f(unsigned short h) { return __uint_as_float(((unsigned)h) << 16); }
__device__ __forceinline__ float wave_sum(float v, int lane) {
#pragma unroll
    for (int o = 32; o >= 1; o >>= 1) v += pg8::shx(v, o, lane);
    return v;
}

__device__ __forceinline__ void prep_weight_unit(PG8_LAS unsigned char* lds, const float* src, int ldsrc, int scol, bf16_t* dst, int K, int n0, int kbeg, int nchunks,
                                                 const float* g, const float* b, float* cs_out, float* bw_out, float f8scale = 0.f) {
    const int tid = pg8::opaque_tid(), c4 = tid & 31, kr = tid >> 5;
    PG8_LAS unsigned char* tile8 = (PG8_LAS unsigned char*)lds;
    PG8_LAS unsigned short* tile = (PG8_LAS unsigned short*)lds;
    float cs[4] = {0.f, 0.f, 0.f, 0.f}, bw[4] = {0.f, 0.f, 0.f, 0.f};
#define PREP_BAR() do { asm volatile("s_waitcnt lgkmcnt(0)" ::: "memory"); __builtin_amdgcn_s_barrier(); asm volatile("" ::: "memory"); } while (0)
    f32x4 wn[4]; float gkn[4], bkn[4];
#pragma unroll
    for (int i = 0; i < 4; ++i) { const int k = kbeg + kr + 16 * i; wn[i] = *(const f32x4*)(src + (size_t)k * ldsrc + scol + 4 * c4); gkn[i] = g ? g[k] : 1.0f; bkn[i] = b ? b[k] : 0.0f; }
    for (int ch = 0; ch < nchunks; ++ch) {
        const int k0 = kbeg + ch * 64;
        f32x4 w[4]; float gk[4], bk[4];
#pragma unroll
        for (int i = 0; i < 4; ++i) { w[i] = wn[i]; gk[i] = gkn[i]; bk[i] = bkn[i]; }
        if (ch + 1 < nchunks) {
#pragma unroll
            for (int i = 0; i < 4; ++i) { const int k = k0 + 64 + kr + 16 * i; wn[i] = *(const f32x4*)(src + (size_t)k * ldsrc + scol + 4 * c4); gkn[i] = g ? g[k] : 1.0f; bkn[i] = b ? b[k] : 0.0f; }
        }
        PREP_BAR();
        if (f8scale != 0.f) {
            const float inv = 1.0f / f8scale;
#pragma unroll
            for (int i = 0; i < 4; ++i) {
                const f32x4 v = w[i] * (gk[i] * f8scale); const unsigned pk = pg8::f8x4(v[0], v[1], v[2], v[3]);
#pragma unroll
                for (int e = 0; e < 4; ++e) { tile8[(4 * c4 + e) * 68 + kr + 16 * i] = (unsigned char)(pk >> (8 * e)); bw[e] += w[i][e] * bk[i]; }
                cs[0] += __builtin_amdgcn_cvt_f32_fp8((int)pk, 0) * inv; cs[1] += __builtin_amdgcn_cvt_f32_fp8((int)pk, 1) * inv; cs[2] += __builtin_amdgcn_cvt_f32_fp8((int)pk, 2) * inv; cs[3] += __builtin_amdgcn_cvt_f32_fp8((int)pk, 3) * inv;
            }
            PREP_BAR();
            const int n = tid >> 2, q = tid & 3;
            const PG8_LAS unsigned* rowp = (const PG8_LAS unsigned*)(tile8 + n * 68 + 16 * q);
            u32x4 o0; o0.x = rowp[0]; o0.y = rowp[1]; o0.z = rowp[2]; o0.w = rowp[3];
            *(u32x4*)((unsigned char*)dst + (size_t)(n0 + n) * K + k0 + 16 * q) = o0;
        } else {
#pragma unroll
        for (int i = 0; i < 4; ++i)
#pragma unroll
            for (int e = 0; e < 4; ++e) { const unsigned short hb = f2bf(w[i][e] * gk[i]); tile[(4 * c4 + e) * 66 + kr + 16 * i] = hb; cs[e] += bf2f(hb); bw[e] += w[i][e] * bk[i]; }
        PREP_BAR();
        const int n = tid >> 2, q = tid & 3;
        const PG8_LAS unsigned* rowp = (const PG8_LAS unsigned*)(tile + n * 66 + 16 * q);
        u32x4 o0, o1; o0.x = rowp[0]; o0.y = rowp[1]; o0.z = rowp[2]; o0.w = rowp[3]; o1.x = rowp[4]; o1.y = rowp[5]; o1.z = rowp[6]; o1.w = rowp[7];
        bf16_t* d = dst + (size_t)(n0 + n) * K + k0 + 16 * q;
        *(u32x4*)d = o0; *(u32x4*)(d + 8) = o1;
        }
    }
    if (cs_out) {
        __syncthreads();
        PG8_LAS float* red = (PG8_LAS float*)(lds + 32768);
#pragma unroll
        for (int e = 0; e < 4; ++e) { red[(kr * 128 + 4 * c4 + e) * 2] = cs[e]; red[(kr * 128 + 4 * c4 + e) * 2 + 1] = bw[e]; }
        __syncthreads();
        if (tid < 128) { float a = 0.f, q = 0.f;
#pragma unroll
            for (int r = 0; r < 16; ++r) { a += red[(r * 128 + tid) * 2]; q += red[(r * 128 + tid) * 2 + 1]; }
            cs_out[n0 + tid] = a; bw_out[n0 + tid] = q; }
    }
    __syncthreads();
}

__device__ __forceinline__ void prep_phase(PG8_LAS unsigned char* lds, const Params& p) {
    unsigned char* ws = p.ws; const int G = gridDim.x;
    for (int it = 0; it < 16; ++it) {
        int idx;
        if (G == 256) {
            const int b = (int)blockIdx.x;
            if (it < 2) { idx = b + 256 * it; if (idx >= 424) continue; }
            else if (b >= 168) { if (it >= 8) break; idx = 424 + 6 * (b - 168) + (it - 2); }
            else { if (it >= 4) break; const int j = 528 + b + 168 * (it - 2); if (j >= 832) continue; idx = 424 + j; }
        } else { idx = (int)blockIdx.x + it * G; if (idx >= 1256) break; }
        if (idx < 352) {
            const int m = idx / 44, strip = idx % 44, l = m >> 1, f = m & 1, pn = strip >> 1, bj = strip & 1;
            const float* src = p.in[f ? 21 : 4] + (size_t)l * 1024 * 5632;
            const float* g = f ? p.in[19] + l * 1024 : (l ? p.in[23] + (l - 1) * 1024 : nullptr);
            const float* b = f ? p.in[20] + l * 1024 : (l ? p.in[24] + (l - 1) * 1024 : nullptr);
            prep_weight_unit(lds, src, 5632, bj * 2816 + 128 * pn, (bf16_t*)(ws + wfi_off(m)), 1024, strip * 128, 0, 16, g, b,
                             (float*)(ws + WS_CSF) + m * 5632, (float*)(ws + WS_BWF) + m * 5632, pg8::is_f8(m) ? pg8::F8_WSCALE : 0.f);
        } else if (idx < 424) {
            const int j = idx - 352, l = j / 18, strip = j % 18;
            prep_weight_unit(lds, p.in[8] + (size_t)l * 1024 * 2304, 2304, strip * 128, (bf16_t*)(ws + WS_WI + l * SZ_WI), 1024, strip * 128, 0, 16, p.in[6] + l * 1024, p.in[7] + l * 1024,
                             (float*)(ws + WS_CSI) + l * 2304, (float*)(ws + WS_BWI) + l * 2304);
        } else if (idx < 1128) {
            const int j = idx - 424, m = j / 88, rem = j % 88, strip = rem / 11, kq = rem % 11, l = m >> 1, f = m & 1;
            prep_weight_unit(lds, p.in[f ? 22 : 5] + (size_t)l * 2816 * 1024, 1024, strip * 128, (bf16_t*)(ws + wfo_off(m)), 2816, strip * 128, kq * 256, 4, nullptr, nullptr, nullptr, nullptr, pg8::is_f8o(m) ? pg8::F8_WOSCALE : 0.f);
        } else {
            const int j = idx - 1128, l = j / 32, rem = j % 32, strip = rem / 4, kq = rem % 4;
            prep_weight_unit(lds, p.in[18] + (size_t)l * 1024 * 1024, 1024, strip * 128, (bf16_t*)(ws + WS_WO + l * SZ_WO), 1024, strip * 128, kq * 256, 4, nullptr, nullptr, nullptr, nullptr);
        }
    }
    const size_t gt = (size_t)blockIdx.x * 512 + pg8::opaque_tid(), gn = (size_t)G * 512;
    bf16_t* P = (bf16_t*)(ws + WS_P);
    for (size_t i = gt; i < (size_t)T_TOK * 1024 / 8; i += gn) {
        const size_t e = i * 8; const float* s = e < (size_t)TP * 1024 ? p.in[0] + e : p.in[1] + (e - (size_t)TP * 1024);
        const f32x4 a = *(const f32x4*)s, c = *(const f32x4*)(s + 4);
        u32x4 w; w.x = cvt_pk_bf16(a[0], a[1]); w.y = cvt_pk_bf16(a[2], a[3]); w.z = cvt_pk_bf16(c[0], c[1]); w.w = cvt_pk_bf16(c[2], c[3]);
        *(u32x4*)(P + e) = w;
        if (pg8::is_f8(0)) *(pg8::u32x2v*)(ws + WS_P8 + e) = (pg8::u32x2v){pg8::f8x4(a[0], a[1], a[2], a[3]), pg8::f8x4(c[0], c[1], c[2], c[3])};
    }
    float* st = (float*)(ws + WS_ST);
    { float one = 1.0f; asm volatile("" : "+v"(one));
      const float idv = one * (1024.0f * (1.0f - 1e-5f)), zz = one * 0.0f;
      for (size_t i = gt; i < (size_t)T_TOK; i += gn) { *(f32x4*)(st + 8 * i) = (f32x4){zz, idv, zz, zz}; *(f32x4*)(st + 8 * i + 4) = (f32x4){zz, zz, zz, zz}; } }
    if (gt < 1024) { ((float*)(ws + WS_ONE))[gt] = 1.0f; ((float*)(ws + WS_ZERO))[gt] = 0.0f; }
}

__device__ __forceinline__ void mixer_a_unit(PG8_LAS unsigned char* lds, int u, int l, const bf16_t* Z, bf16_t* MX, const Params& p) {
    const int tid = pg8::opaque_tid(), tb = u * 32;
    const bool samp = tb >= TP;
    int b, t0, T, seqbase;
    if (!samp) { b = tb >> 13; t0 = tb & 8191; T = 8192; seqbase = b << 13; } else { const int rs = tb - TP; b = rs >> 6; t0 = rs & 63; T = 64; seqbase = TP + (b << 6); }
    PG8_LAS unsigned short* ae = (PG8_LAS unsigned short*)lds;
    PG8_LAS float* cv = (PG8_LAS float*)(lds + 49152);
    __syncthreads();
    {
        const bool wr_state = (t0 + 32 == T);
        float* so = samp ? p.out + O_SAS + (size_t)(l * 16 + b) * 30 * 384 : p.out + O_SAP + (size_t)(l * 4 + b) * 30 * 384;
        const float* hist = p.in[2] + (size_t)(l * 16 + b) * 30 * 384;
        if (t0 != 0) {
            u32x4 pwv[6], gwv[6];
#pragma unroll
            for (int q = 0; q < 6; ++q) { int it = tid + 512 * q; it = it < 62 * 48 ? it : 0; const int i = it / 48, c = (it - i * 48) * 8;
                const char* zr = (const char*)Z + ((unsigned)(seqbase + t0 - 30 + i) * 4608u + (unsigned)c * 2u); pwv[q] = *(const u32x4*)zr; gwv[q] = *(const u32x4*)(zr + 768); }
#pragma unroll
            for (int q = 0; q < 6; ++q) { const int it = tid + 512 * q; if (it < 62 * 48) { const int i = it / 48, c = (it - i * 48) * 8; const u32x4 pw = pwv[q], gw = gwv[q]; float a[8];
                a[0] = bf_lo(pw.x) * sigmoid_f(bf_lo(gw.x)); a[1] = bf_hi(pw.x) * sigmoid_f(bf_hi(gw.x)); a[2] = bf_lo(pw.y) * sigmoid_f(bf_lo(gw.y)); a[3] = bf_hi(pw.y) * sigmoid_f(bf_hi(gw.y));
                a[4] = bf_lo(pw.z) * sigmoid_f(bf_lo(gw.z)); a[5] = bf_hi(pw.z) * sigmoid_f(bf_hi(gw.z)); a[6] = bf_lo(pw.w) * sigmoid_f(bf_lo(gw.w)); a[7] = bf_hi(pw.w) * sigmoid_f(bf_hi(gw.w));
                u32x4 w; w.x = cvt_pk_bf16(a[0], a[1]); w.y = cvt_pk_bf16(a[2], a[3]); w.z = cvt_pk_bf16(a[4], a[5]); w.w = cvt_pk_bf16(a[6], a[7]);
                *(PG8_LAS u32x4*)(ae + i * 384 + c) = w;
                if (wr_state && i >= 32) { float* d = so + (i - 32) * 384 + c; *(f32x4*)d = (f32x4){a[0], a[1], a[2], a[3]}; *(f32x4*)(d + 4) = (f32x4){a[4], a[5], a[6], a[7]}; } } }
        } else
        for (int it = tid; it < 62 * 48; it += 512) {
            const int i = it / 48, c = (it - i * 48) * 8, t = t0 - 30 + i;
            float a[8];
            if (t >= 0) {
                const char* zr = (const char*)Z + ((unsigned)(seqbase + t) * 4608u + (unsigned)c * 2u);
                const u32x4 pw = *(const u32x4*)zr, gw = *(const u32x4*)(zr + 768);
                a[0] = bf_lo(pw.x) * sigmoid_f(bf_lo(gw.x)); a[1] = bf_hi(pw.x) * sigmoid_f(bf_hi(gw.x)); a[2] = bf_lo(pw.y) * sigmoid_f(bf_lo(gw.y)); a[3] = bf_hi(pw.y) * sigmoid_f(bf_hi(gw.y));
                a[4] = bf_lo(pw.z) * sigmoid_f(bf_lo(gw.z)); a[5] = bf_hi(pw.z) * sigmoid_f(bf_hi(gw.z)); a[6] = bf_lo(pw.w) * sigmoid_f(bf_lo(gw.w)); a[7] = bf_hi(pw.w) * sigmoid_f(bf_hi(gw.w));
            } else if (samp) {
                const f32x4 h0 = *(const f32x4*)(hist + (30 + t) * 384 + c), h1 = *(const f32x4*)(hist + (30 + t) * 384 + c + 4);
#pragma unroll
                for (int e = 0; e < 4; ++e) { a[e] = h0[e]; a[4 + e] = h1[e]; }
            } else {
#pragma unroll
                for (int e = 0; e < 8; ++e) a[e] = 0.f;
            }
            u32x4 w; w.x = cvt_pk_bf16(a[0], a[1]); w.y = cvt_pk_bf16(a[2], a[3]); w.z = cvt_pk_bf16(a[4], a[5]); w.w = cvt_pk_bf16(a[6], a[7]);
            *(PG8_LAS u32x4*)(ae + i * 384 + c) = w;
            if (wr_state && i >= 32) { float* d = so + (i - 32) * 384 + c; *(f32x4*)d = (f32x4){a[0], a[1], a[2], a[3]}; *(f32x4*)(d + 4) = (f32x4){a[4], a[5], a[6], a[7]}; }
        }
    }
    __syncthreads();
    if (tid < 384) {
        const int th = tid >= 192 ? 1 : 0, c = 2 * (tid - 192 * th);
        pg8::f32x2 av[46];
#pragma unroll
        for (int i = 0; i < 46; ++i) { const unsigned w = *(const PG8_LAS unsigned*)(ae + (16 * th + i) * 384 + c); av[i] = (pg8::f32x2){bf_lo(w), bf_hi(w)}; }
        pg8::f32x2 wv[31];
        const float* cw = p.in[9] + (size_t)l * 31 * 384 + c;
#pragma unroll
        for (int k = 0; k < 31; ++k) wv[k] = *(const pg8::f32x2*)(cw + k * 384);
        const pg8::f32x2 bias = *(const pg8::f32x2*)(p.in[10] + l * 384 + c);
#pragma unroll
        for (int j = 0; j < 16; ++j) { pg8::f32x2 acc = bias;
#pragma unroll
            for (int k = 0; k < 31; ++k) acc += wv[k] * av[j + k];
            *(PG8_LAS pg8::f32x2*)(cv + (16 * th + j) * 384 + c) = acc; }
    }
    __syncthreads();
    const int wave = tid >> 6, lane = tid & 63;
    const float* ng = p.in[11] + l * 384; const float* nb = p.in[12] + l * 384;
    pg8::f32x2 gg[3], bb[3];
#pragma unroll
    for (int i = 0; i < 3; ++i) { gg[i] = *(const pg8::f32x2*)(ng + 2 * (lane + 64 * i)); bb[i] = *(const pg8::f32x2*)(nb + 2 * (lane + 64 * i)); }
    pg8::f32x2 x[4][3]; float sm[4], sq[4];
#pragma unroll
    for (int tt = 0; tt < 4; ++tt) { sm[tt] = 0.f;
#pragma unroll
        for (int i = 0; i < 3; ++i) { x[tt][i] = *(const PG8_LAS pg8::f32x2*)(cv + (wave * 4 + tt) * 384 + 2 * (lane + 64 * i)); sm[tt] += x[tt][i][0] + x[tt][i][1]; } }
#pragma unroll
    for (int o = 32; o >= 1; o >>= 1)
#pragma unroll
        for (int tt = 0; tt < 4; ++tt) sm[tt] += pg8::shx(sm[tt], o, lane);
#pragma unroll
    for (int tt = 0; tt < 4; ++tt) { const float mean = sm[tt] * (1.0f / 384.0f); sq[tt] = 0.f;
#pragma unroll
        for (int i = 0; i < 3; ++i) { x[tt][i] -= mean; sq[tt] += x[tt][i][0] * x[tt][i][0] + x[tt][i][1] * x[tt][i][1]; } }
#pragma unroll
    for (int o = 32; o >= 1; o >>= 1)
#pragma unroll
        for (int tt = 0; tt < 4; ++tt) sq[tt] += pg8::shx(sq[tt], o, lane);
#pragma unroll
    for (int tt = 0; tt < 4; ++tt) {
        const unsigned row = (unsigned)(seqbase + t0 + wave * 4 + tt);
        const float rstd = rsqrtf(sq[tt] * (1.0f / 384.0f) + LN_EPS_F);
#pragma unroll
        for (int i = 0; i < 3; ++i) { const float y0 = x[tt][i][0] * rstd * gg[i][0] + bb[i][0], y1 = x[tt][i][1] * rstd * gg[i][1] + bb[i][1];
            *(unsigned*)((char*)MX + (row * 2048u + 4u * (unsigned)(lane + 64 * i))) = cvt_pk_bf16(silu_f(y0), silu_f(y1)); }
    }
}
__device__ __forceinline__ void mixer_b_unit(PG8_LAS unsigned char* lds, int blk, int l, const bf16_t* Z, bf16_t* MX, const Params& p) {
    const int tid = pg8::opaque_tid(), wave = tid >> 6, lane = tid & 63, fr = lane & 15, fq = lane >> 4;
    const int row0 = blk * 128; const bool samp = row0 >= TP;
    const float* ng = p.in[13] + l * 384; const float* nb = p.in[14] + l * 384;
    PG8_LAS unsigned short* vT = (PG8_LAS unsigned short*)lds;
    __syncthreads();
    float gg[6], bb[6];
#pragma unroll
    for (int i = 0; i < 3; ++i) { const int c = 2 * lane + 128 * i; gg[2 * i] = ng[c]; gg[2 * i + 1] = ng[c + 1]; bb[2 * i] = nb[c]; bb[2 * i + 1] = nb[c + 1]; }
    for (int g8 = 0; g8 < 2; ++g8) {
        unsigned pk[6][4];
        unsigned zw[8][3];
#pragma unroll
        for (int jj = 0; jj < 8; ++jj)
#pragma unroll
            for (int i = 0; i < 3; ++i) zw[jj][i] = *(const unsigned*)((const char*)Z + ((unsigned)(row0 + wave * 16 + g8 * 8 + jj) * 4608u + 2304u + 4u * (unsigned)lane + 256u * i));
        float v[8][6], sm[8], sq[8];
#pragma unroll
        for (int jj = 0; jj < 8; ++jj) { sm[jj] = 0.f;
#pragma unroll
            for (int i = 0; i < 3; ++i) { const unsigned w = zw[jj][i]; v[jj][2 * i] = bf_lo(w); v[jj][2 * i + 1] = bf_hi(w); sm[jj] += v[jj][2 * i] + v[jj][2 * i + 1]; } }
#pragma unroll
        for (int o = 32; o >= 1; o >>= 1)
#pragma unroll
            for (int jj = 0; jj < 8; ++jj) sm[jj] += pg8::shx(sm[jj], o, lane);
#pragma unroll
        for (int jj = 0; jj < 8; ++jj) { const float mean = sm[jj] * (1.0f / 384.0f); sq[jj] = 0.f;
#pragma unroll
            for (int i = 0; i < 6; ++i) { v[jj][i] -= mean; sq[jj] += v[jj][i] * v[jj][i]; } }
#pragma unroll
        for (int o = 32; o >= 1; o >>= 1)
#pragma unroll
            for (int jj = 0; jj < 8; ++jj) sq[jj] += pg8::shx(sq[jj], o, lane);
#pragma unroll
        for (int jj = 0; jj < 8; ++jj) {
            const unsigned row = (unsigned)(row0 + wave * 16 + g8 * 8 + jj);
            const float rstd = rsqrtf(sq[jj] * (1.0f / 384.0f) + LN_EPS_F);
#pragma unroll
            for (int i = 0; i < 6; ++i) v[jj][i] = v[jj][i] * rstd * gg[i] + bb[i];
            if (samp) {
#pragma unroll
                for (int i = 0; i < 3; ++i) *(pg8::f32x2*)(p.out + O_SVS + ((size_t)l * 1024 + (row - TP)) * 384 + 2 * lane + 128 * i) = (pg8::f32x2){v[jj][2 * i], v[jj][2 * i + 1]};
            }
#pragma unroll
            for (int i = 0; i < 6; ++i) { const unsigned hb = f2bf(v[jj][i]); if (jj & 1) pk[i][jj >> 1] |= hb << 16; else pk[i][jj >> 1] = hb; }
        }
#pragma unroll
        for (int i = 0; i < 6; ++i) { const int c = 2 * lane + 128 * (i >> 1) + (i & 1); u32x4 w; w.x = pk[i][0]; w.y = pk[i][1]; w.z = pk[i][2]; w.w = pk[i][3];
            *(PG8_LAS u32x4*)(vT + c * 136 + wave * 16 + g8 * 8) = w; }
    }
    __syncthreads();
    const int i_loc = wave * 16 + fr;
    const size_t orow = (size_t)(row0 + i_loc);
#pragma unroll 2
    for (int h = 0; h < 6; ++h) {
        f32x4 acc[4];
#pragma unroll
        for (int dt = 0; dt < 4; ++dt) acc[dt] = (f32x4){0.f, 0.f, 0.f, 0.f};
        const float* wh = p.in[15] + (size_t)(l * 6 + h) * 128 * 128;
        f32x4 wq[4][2]; u32x2 uw[4];
#pragma unroll
        for (int ks = 0; ks < 4; ++ks) {
            const int j0 = ks * 32 + fq * 8;
            bool valid; const float* src;
            if (!samp) { valid = (j0 >> 6) <= (i_loc >> 6); src = wh + i_loc * 128 + j0; }
            else { valid = (j0 >> 6) == (i_loc >> 6); src = wh + (i_loc & 63) * 128 + (j0 & 63); }
            wq[ks][0] = *(const f32x4*)src; wq[ks][1] = *(const f32x4*)(src + 4);
            if (!valid) { wq[ks][0] = (f32x4){0.f, 0.f, 0.f, 0.f}; wq[ks][1] = wq[ks][0]; }
        }
#pragma unroll
        for (int dt = 0; dt < 4; ++dt) uw[dt] = *(const u32x2*)((const char*)Z + ((unsigned)orow * 4608u + 1536u + 2u * (unsigned)(h * 64 + dt * 16 + fq * 4)));
#pragma unroll
        for (int ks = 0; ks < 4; ++ks) {
            const int j0 = ks * 32 + fq * 8;
            union { bf16x8 v; unsigned u[4]; } wf;
            wf.u[0] = cvt_pk_bf16(wq[ks][0][0], wq[ks][0][1]); wf.u[1] = cvt_pk_bf16(wq[ks][0][2], wq[ks][0][3]); wf.u[2] = cvt_pk_bf16(wq[ks][1][0], wq[ks][1][1]); wf.u[3] = cvt_pk_bf16(wq[ks][1][2], wq[ks][1][3]);
#pragma unroll
            for (int dt = 0; dt < 4; ++dt) {
                const bf16x8 vf = *(const PG8_LAS bf16x8*)(vT + (h * 64 + dt * 16 + fr) * 136 + j0);
                acc[dt] = __builtin_amdgcn_mfma_f32_16x16x32_bf16(vf, wf.v, acc[dt], 0, 0, 0);
            }
        }
        const float bias = p.in[16][(l * 6 + h) * 128 + (samp ? (i_loc & 63) : i_loc)];
#pragma unroll
        for (int dt = 0; dt < 4; ++dt) {
            const int d = h * 64 + dt * 16 + fq * 4;
            const float o0 = bf_lo(uw[dt].x) * (acc[dt][0] + bias), o1 = bf_hi(uw[dt].x) * (acc[dt][1] + bias), o2 = bf_lo(uw[dt].y) * (acc[dt][2] + bias), o3 = bf_hi(uw[dt].y) * (acc[dt][3] + bias);
            u32x2 ow; ow.x = cvt_pk_bf16(o0, o1); ow.y = cvt_pk_bf16(o2, o3);
            *(u32x2*)(MX + orow * 1024 + 384 + d) = ow;
        }
    }
}
__device__ __forceinline__ void mixer_c_items(int l, const bf16_t* Z, bf16_t* MX, const Params& p) {
    const unsigned gt = blockIdx.x * 512u + (unsigned)pg8::opaque_tid(), gn = gridDim.x * 512u;
    const char* Zb = (const char*)Z;
    for (unsigned it = gt; it < (unsigned)T_TOK * 32u; it += gn) {
        const int row = (int)(it >> 5), c = (int)(it & 31) * 8;
        const bool samp = row >= TP;
        int b, t, T; if (!samp) { b = row >> 13; t = row & 8191; T = 8192; } else { const int rs = row - TP; b = rs >> 6; t = rs & 63; T = 64; }
        float cx[3][8];
        if (t >= 2) {
            u32x4 xw[3], gw[3];
#pragma unroll
            for (int k = 0; k < 3; ++k) { const unsigned ro = (unsigned)(row - 2 + k) * 4608u + (unsigned)c * 2u; xw[k] = *(const u32x4*)(Zb + ro + 3072u); gw[k] = *(const u32x4*)(Zb + ro + 4096u); }
#pragma unroll
            for (int k = 0; k < 3; ++k) {
                cx[k][0] = bf_lo(xw[k].x) * bf_lo(gw[k].x); cx[k][1] = bf_hi(xw[k].x) * bf_hi(gw[k].x); cx[k][2] = bf_lo(xw[k].y) * bf_lo(gw[k].y); cx[k][3] = bf_hi(xw[k].y) * bf_hi(gw[k].y);
                cx[k][4] = bf_lo(xw[k].z) * bf_lo(gw[k].z); cx[k][5] = bf_hi(xw[k].z) * bf_hi(gw[k].z); cx[k][6] = bf_lo(xw[k].w) * bf_lo(gw[k].w); cx[k][7] = bf_hi(xw[k].w) * bf_hi(gw[k].w);
            }
        } else
#pragma unroll
        for (int k = 0; k < 3; ++k) {
            const int tt = t - 2 + k;
            if (tt >= 0) {
                const unsigned ro = (unsigned)(row - 2 + k) * 4608u + (unsigned)c * 2u;
                const u32x4 xw = *(const u32x4*)(Zb + ro + 3072u), gw = *(const u32x4*)(Zb + ro + 4096u);
                cx[k][0] = bf_lo(xw.x) * bf_lo(gw.x); cx[k][1] = bf_hi(xw.x) * bf_hi(gw.x); cx[k][2] = bf_lo(xw.y) * bf_lo(gw.y); cx[k][3] = bf_hi(xw.y) * bf_hi(gw.y);
                cx[k][4] = bf_lo(xw.z) * bf_lo(gw.z); cx[k][5] = bf_hi(xw.z) * bf_hi(gw.z); cx[k][6] = bf_lo(xw.w) * bf_lo(gw.w); cx[k][7] = bf_hi(xw.w) * bf_hi(gw.w);
            } else if (samp) {
                const float* hc = p.in[3] + ((size_t)(l * 16 + b) * 2 + (2 + tt)) * 256 + c;
                const f32x4 h0 = *(const f32x4*)hc, h1 = *(const f32x4*)(hc + 4);
#pragma unroll
                for (int e = 0; e < 4; ++e) { cx[k][e] = h0[e]; cx[k][4 + e] = h1[e]; }
            } else {
#pragma unroll
                for (int e = 0; e < 8; ++e) cx[k][e] = 0.f;
            }
        }
        const u32x4 gb = *(const u32x4*)(Zb + ((unsigned)row * 4608u + 3584u + (unsigned)c * 2u));
        float gbf[8]; gbf[0] = bf_lo(gb.x); gbf[1] = bf_hi(gb.x); gbf[2] = bf_lo(gb.y); gbf[3] = bf_hi(gb.y); gbf[4] = bf_lo(gb.z); gbf[5] = bf_hi(gb.z); gbf[6] = bf_lo(gb.w); gbf[7] = bf_hi(gb.w);
        float o[8];
#pragma unroll
        for (int e = 0; e < 8; ++e) o[e] = 0.f;
#pragma unroll
        for (int k = 0; k < 3; ++k) {
            const float* wk = p.in[17] + (size_t)(l * 3 + k) * 256 + c;
            const f32x4 w0 = *(const f32x4*)wk, w1 = *(const f32x4*)(wk + 4);
#pragma unroll
            for (int e = 0; e < 4; ++e) { o[e] += w0[e] * cx[k][e]; o[4 + e] += w1[e] * cx[k][4 + e]; }
        }
        u32x4 ow; ow.x = cvt_pk_bf16(gbf[0] * o[0], gbf[1] * o[1]); ow.y = cvt_pk_bf16(gbf[2] * o[2], gbf[3] * o[3]); ow.z = cvt_pk_bf16(gbf[4] * o[4], gbf[5] * o[5]); ow.w = cvt_pk_bf16(gbf[6] * o[6], gbf[7] * o[7]);
        *(u32x4*)((char*)MX + ((unsigned)row * 2048u + 1536u + (unsigned)c * 2u)) = ow;
        if (t >= T - 2) {
            float* so = (samp ? p.out + O_SCS + ((size_t)(l * 16 + b) * 2 + (t - (T - 2))) * 256 : p.out + O_SCP + ((size_t)(l * 4 + b) * 2 + (t - (T - 2))) * 256) + c;
            *(f32x4*)so = (f32x4){cx[2][0], cx[2][1], cx[2][2], cx[2][3]}; *(f32x4*)(so + 4) = (f32x4){cx[2][4], cx[2][5], cx[2][6], cx[2][7]};
        }
    }
}
__device__ __forceinline__ void mixer_phase(PG8_LAS unsigned char* lds, int l, const Params& p) {
    const bf16_t* Z = (const bf16_t*)(p.ws + WS_H); bf16_t* MX = (bf16_t*)(p.ws + WS_MX); const int G = gridDim.x;
    for (int ub = blockIdx.x; ub < 264; ub += G) mixer_b_unit(lds, ub, l, Z, MX, p);
    for (int ua = G - 1 - blockIdx.x; ua < 1056; ua += G) mixer_a_unit(lds, ua, l, Z, MX, p);
    mixer_c_items(l, Z, MX, p);
    __syncthreads();
}
__device__ __forceinline__ void sample_reduce(const Params& p, unsigned char* ws, const float* st_old, const float* g, const float* b, float* st_new, float scale, unsigned char* p8) {
    const int tid = pg8::opaque_tid(), wave = tid >> 6, lane = tid & 63;
    const bf16_t* part = (const bf16_t*)(ws + WS_PART); bf16_t* P = (bf16_t*)(ws + WS_P);
    for (int it = blockIdx.x * 8 + wave; it < 4096; it += gridDim.x * 8) {
        const int rl = it >> 2, pn = it & 3, r = TP + rl, c = pn * 256 + 4 * lane;
        const size_t po = (size_t)rl * 1024 + c;
        f32x4 q0, q1, q2, q3;
        { const u32x2 w0 = *(const u32x2*)(part + po), w1 = *(const u32x2*)(part + po + 1048576), w2 = *(const u32x2*)(part + po + 2 * 1048576), w3 = *(const u32x2*)(part + po + 3 * 1048576);
          q0 = (f32x4){bf_lo(w0.x), bf_hi(w0.x), bf_lo(w0.y), bf_hi(w0.y)}; q1 = (f32x4){bf_lo(w1.x), bf_hi(w1.x), bf_lo(w1.y), bf_hi(w1.y)};
          q2 = (f32x4){bf_lo(w2.x), bf_hi(w2.x), bf_lo(w2.y), bf_hi(w2.y)}; q3 = (f32x4){bf_lo(w3.x), bf_hi(w3.x), bf_lo(w3.y), bf_hi(w3.y)}; }
        const f32x4 acc = ((q0 + q1) + q2) + q3;
        float mu, rs; pg8::row_stats(st_old, r, mu, rs); rs *= pg8::ALPHA_F;
        const u32x2 pw = *(const u32x2*)(P + (size_t)r * 1024 + c);
        f32x4 x; x[0] = bf_lo(pw.x); x[1] = bf_hi(pw.x); x[2] = bf_lo(pw.y); x[3] = bf_hi(pw.y);
        const f32x4 gv = *(const f32x4*)(g + c), bv = *(const f32x4*)(b + c);
        f32x4 v = ((x - mu) * rs) * gv + (bv * pg8::ALPHA_F + scale * acc);
        { u32x2 w; w.x = cvt_pk_bf16(v[0], v[1]); w.y = cvt_pk_bf16(v[2], v[3]); *(u32x2*)(P + (size_t)r * 1024 + c) = w;
            if (p8) *(unsigned*)(p8 + (size_t)r * 1024 + c) = pg8::f8x4(v[0], v[1], v[2], v[3]);
            v[0] = bf_lo(w.x); v[1] = bf_hi(w.x); v[2] = bf_lo(w.y); v[3] = bf_hi(w.y); }
        const float sm = wave_sum((v[0] + v[1]) + (v[2] + v[3]), lane), sq = wave_sum((v[0] * v[0] + v[1] * v[1]) + (v[2] * v[2] + v[3] * v[3]), lane);
        if (lane == 0) *(pg8::f32x2*)(st_new + 8 * (size_t)r + 2 * pn) = (pg8::f32x2){sm, sq};
    }
}
__device__ __forceinline__ void final_phase(const Params& p) {
    const float* st = (const float*)(p.ws + WS_ST + 12 * SZ_ST); const float* g = p.in[23] + 3 * 1024; const float* b = p.in[24] + 3 * 1024;
    const size_t gt = (size_t)blockIdx.x * 512 + pg8::opaque_tid(), gn = (size_t)gridDim.x * 512;
    const bf16_t* P = (const bf16_t*)(p.ws + WS_P);
    for (size_t i = gt; i < (size_t)T_TOK * 128; i += gn) {
        const int r = (int)(i >> 7), c = (int)(i & 127) * 8; float mu, rstd; pg8::row_stats(st, r, mu, rstd);
        const u32x4 w = *(const u32x4*)(P + (size_t)r * 1024 + c);
        f32x4 v0, v1; v0[0] = bf_lo(w.x); v0[1] = bf_hi(w.x); v0[2] = bf_lo(w.y); v0[3] = bf_hi(w.y); v1[0] = bf_lo(w.z); v1[1] = bf_hi(w.z); v1[2] = bf_lo(w.w); v1[3] = bf_hi(w.w);
        const f32x4 g0 = *(const f32x4*)(g + c), g1 = *(const f32x4*)(g + c + 4), b0 = *(const f32x4*)(b + c), b1 = *(const f32x4*)(b + c + 4);
        *(f32x4*)(p.out + (size_t)r * 1024 + c) = (v0 - mu) * rstd * g0 + b0; *(f32x4*)(p.out + (size_t)r * 1024 + c + 4) = (v1 - mu) * rstd * g1 + b1;
    }
}

__global__ void __launch_bounds__(512, 2) fwd_kernel(Params p) {
    extern __shared__ __attribute__((aligned(16))) unsigned char shm[];
    PG8_LAS unsigned char* lds = (PG8_LAS unsigned char*)shm;
    unsigned char* ws0 = p.ws; const int G = gridDim.x;
    unsigned char* ws = ws0;
    if (threadIdx.x < 4) ((PG8_LAS unsigned*)(lds + 131072))[threadIdx.x] = 0u;
    __syncthreads();
    XcdBarrier xbar = xcd_barrier_post((unsigned*)(ws + WS_BAR), (volatile LAS unsigned*)(lds + 131072));
    for (int ph = p.lo; ph < p.hi; ++ph) {
        { unsigned long long wsi = (unsigned long long)ws0; asm volatile("" : "+s"(wsi));
          ws = (unsigned char*)(__attribute__((address_space(1))) unsigned char*)wsi; }
        bf16_t* P = (bf16_t*)(ws + WS_P); bf16_t* H = (bf16_t*)(ws + WS_H); bf16_t* MX = (bf16_t*)(ws + WS_MX);
        float* ST = (float*)(ws + WS_ST);
        const bf16_t* sp_A = nullptr; const bf16_t* sp_B = nullptr; const float* sp_go = nullptr; const float* sp_bo = nullptr; const float* sp_stold = nullptr; float* sp_stnew = nullptr; unsigned char* sp_p8 = nullptr; float sp_scale = 0.f; int sp_K = 0; bool do_split = false;
#ifndef NO_PREP
        if (ph == 0) { prep_phase(lds, p); } else
#endif
        if (ph == N_PHASES - 1) final_phase(p);
        else {
            const int l = (ph - 1) / 7, s = (ph - 1) % 7;
            if (s == 0 || s == 5) {
                const int f = s == 5, m = l * 2 + f;
                pg8::StaticOrder S; S.init(T_TOK, 5632, G, (int)blockIdx.x);
                pg8::EpiSwiGLU E{H, ST + (size_t)(f ? 2 + 3 * l : 3 * l) * T_TOK * 8, (const float*)(ws + WS_CSF) + m * 5632, (const float*)(ws + WS_BWF) + m * 5632, pg8::is_f8(m) ? 1.0f / pg8::F8_WSCALE : 1.0f, pg8::is_f8o(m) ? pg8::F8_HSCALE : 0.f, lds + 131072 + 16};
#ifndef NO_SWI
                if (pg8::is_f8(m)) { pg8::Gemm g{(const bf16_t*)(ws + WS_P8), (const bf16_t*)(ws + wfi_off(m)), T_TOK, 5632, 512, 512};
                    pg8::gemm_phase<pg8::EpiSwiGLU, pg8::StaticOrder, false, true>(lds, g, S, E, nullptr); }
                else { pg8::Gemm g{P, (const bf16_t*)(ws + wfi_off(m)), T_TOK, 5632, 1024, 1024};
                    pg8::gemm_phase<pg8::EpiSwiGLU, pg8::StaticOrder, false, false>(lds, g, S, E, nullptr); }
#endif
            } else if (s == 1 || s == 6) {
                const int f = s == 6, m = l * 2 + f;
                const bool o8 = pg8::is_f8o(m);
                pg8::Gemm g{H, (const bf16_t*)(ws + wfo_off(m)), TP, 1024, o8 ? 1408 : 2816, o8 ? 1408 : 2816}; pg8::StaticOrder S; S.init(TP, 1024, G, (int)blockIdx.x);
                const float* go = f ? p.in[19] + l * 1024 : (l ? p.in[23] + (l - 1) * 1024 : (const float*)(ws + WS_ONE));
                const float* bo = f ? p.in[20] + l * 1024 : (l ? p.in[24] + (l - 1) * 1024 : (const float*)(ws + WS_ZERO));
                const float osc = o8 ? 0.5f / (pg8::F8_HSCALE * pg8::F8_WOSCALE) : 0.5f;
                unsigned char* p8w = (f && l < NL - 1 && pg8::is_f8(2 * l + 2)) ? ws + WS_P8 : nullptr;
                pg8::EpiRes E{P, p8w, ST + (size_t)(f ? 2 + 3 * l : 3 * l) * T_TOK * 8, go, bo, ST + (size_t)(f ? 3 + 3 * l : 1 + 3 * l) * T_TOK * 8, osc, lds + 131072 + 16};
#ifndef NO_RES
                if (o8) pg8::gemm_phase<pg8::EpiRes, pg8::StaticOrder, false, true>(lds, g, S, E, nullptr);
                else pg8::gemm_phase<pg8::EpiRes, pg8::StaticOrder, false, false>(lds, g, S, E, nullptr);
#endif
                sp_A = o8 ? (const bf16_t*)((const unsigned char*)H + (size_t)TP * 2816) : H + (size_t)TP * 2816; sp_B = g.Bt; sp_K = o8 ? 1408 : 2816; sp_go = go; sp_bo = bo; sp_stold = E.st_old; sp_stnew = E.st_new; sp_scale = osc; sp_p8 = p8w; do_split = true;
            } else if (s == 2) {
                pg8::Gemm g{P, (const bf16_t*)(ws + WS_WI + l * SZ_WI), T_TOK, 2304, 1024, 1024}; pg8::StaticOrder S; S.init(T_TOK, 2304, G, (int)blockIdx.x);
                pg8::EpiZ E{H, ST + (size_t)(1 + 3 * l) * T_TOK * 8, (const float*)(ws + WS_CSI) + l * 2304, (const float*)(ws + WS_BWI) + l * 2304, lds + 131072 + 16};
#ifndef NO_Z
                pg8::gemm_phase<pg8::EpiZ, pg8::StaticOrder, false>(lds, g, S, E, nullptr);
#endif
            } else if (s == 3) {
#ifndef NO_MIX
                mixer_phase(lds, l, p);
#endif
            } else {
                pg8::Gemm g{MX, (const bf16_t*)(ws + WS_WO + l * SZ_WO), TP, 1024, 1024, 1024}; pg8::StaticOrder S; S.init(TP, 1024, G, (int)blockIdx.x);
                unsigned char* p8w = pg8::is_f8(2 * l + 1) ? ws + WS_P8 : nullptr;
                pg8::EpiRes E{P, p8w, ST + (size_t)(1 + 3 * l) * T_TOK * 8, p.in[6] + l * 1024, p.in[7] + l * 1024, ST + (size_t)(2 + 3 * l) * T_TOK * 8, 1.0f, lds + 131072 + 16};
#ifndef NO_RES
                pg8::gemm_phase<pg8::EpiRes, pg8::StaticOrder, false>(lds, g, S, E, nullptr);
#endif
                sp_A = MX + (size_t)TP * 1024; sp_B = g.Bt; sp_K = 1024; sp_go = E.g; sp_bo = E.b; sp_stold = E.st_old; sp_stnew = E.st_new; sp_scale = 1.0f; sp_p8 = p8w; do_split = true;
            }
            if (do_split) {
                for (int idx = (int)blockIdx.x - (G >= 64 ? G - 64 : 0); idx >= 0 && idx < 64; idx += G) {
                    const int sp = idx >> 4, tile = idx & 15;
                    const int k0 = sp_K == 2816 ? (sp < 2 ? sp * 768 : 1536 + (sp - 2) * 640) : (sp_K == 1408 ? sp * 384 : sp * 256), kl = sp_K == 2816 ? (sp < 2 ? 768 : 640) : (sp_K == 1408 ? (sp < 3 ? 384 : 256) : 256);
                    pg8::Gemm g2{sp_A + k0, sp_B + k0, 1024, 1024, kl, sp_K}; pg8::SingleUnit S2{tile >> 2, tile & 3};
                    pg8::EpiPart E2{(bf16_t*)(ws + WS_PART) + (size_t)sp * 1048576};
                    if (sp_K == 1408) pg8::gemm_phase<pg8::EpiPart, pg8::SingleUnit, false, true>(lds, g2, S2, E2, nullptr);
                    else pg8::gemm_phase<pg8::EpiPart, pg8::SingleUnit, false, false>(lds, g2, S2, E2, nullptr);
                }
                xcd_barrier(xbar);
                sample_reduce(p, ws, sp_stold, sp_go, sp_bo, sp_stnew, sp_scale, sp_p8);
            }
        }
        if (ph + 1 < p.hi) { if (ph == 0) cg::this_grid().sync(); else xcd_barrier(xbar); }
    }
}

#ifndef N_LAUNCH_MODE
#define N_LAUNCH_MODE 1
#endif
extern "C" void kernel_launch(void* const* d_in, const int* in_sizes, int n_in, void* d_out, int out_size, void* d_ws, size_t ws_size, hipStream_t stream) {
    static int grid = 0;
    if (grid == 0) {
        if (n_in != 25 || ws_size < WS_END) { fprintf(stderr, "kernel_launch: need 25 inputs and %zu bytes of workspace; got %d, %zu\n", (size_t)WS_END, n_in, ws_size); grid = -1; return; }
        int dev = 0, cus = 0, per_cu = 0;
        hipGetDevice(&dev); hipDeviceGetAttribute(&cus, hipDeviceAttributeMultiprocessorCount, dev);
        if (hipFuncSetAttribute((const void*)fwd_kernel, hipFuncAttributeMaxDynamicSharedMemorySize, LDS_BYTES) != hipSuccess) { fprintf(stderr, "kernel_launch: hipFuncSetAttribute failed\n"); grid = -1; return; }
        if (hipOccupancyMaxActiveBlocksPerMultiprocessor(&per_cu, (const void*)fwd_kernel, 512, LDS_BYTES) != hipSuccess || per_cu < 1) { fprintf(stderr, "kernel_launch: occupancy query says %d\n", per_cu); per_cu = 1; }
        (void)hipGetLastError();
        grid = cus * per_cu;
        fprintf(stderr, "kernel_launch: grid %d (cus %d x %d)\n", grid, cus, per_cu);
    }
    if (grid < 0) return;
    if (hipMemsetAsync((char*)d_ws + WS_BAR, 0, 16384, stream) != hipSuccess) { fprintf(stderr, "kernel_launch: memset failed\n"); return; }
    Params p{};
    for (int i = 0; i < 25; ++i) p.in[i] = (const float*)d_in[i];
    p.out = (float*)d_out; p.ws = (unsigned char*)d_ws;
#if N_LAUNCH_MODE == 1
    p.lo = 0; p.hi = N_PHASES;
    void* args[] = {&p};
    hipError_t e = hipLaunchCooperativeKernel((const void*)fwd_kernel, dim3(grid), dim3(512), args, LDS_BYTES, stream);
    if (e != hipSuccess) fprintf(stderr, "cooperative launch failed: %s (grid %d)\n", hipGetErrorString(e), grid);
#else
    for (int ph = 0; ph < N_PHASES; ++ph) {
        p.lo = ph; p.hi = ph + 1;
        hipLaunchKernelGGL(fwd_kernel, dim3(grid), dim3(512), LDS_BYTES, stream, p);
    }
#endif
}
```
